# Optimizing an MI355X kernel written in HIP

```python
import math
import jax, jax.numpy as jnp
from jax import lax
import numpy as np

D_MODEL = 2048
BATCH = 1
SEQ = 8192
DEPTH = 4

EPS = 1e-6
N_BRANCH = 4
BRANCH_WIDTH = 512
A_GROUPS = ((128, 1), (512, 4), (2048, 16))
A_HEADS_PER_GROUP = 4
A_HEAD_DIM = 128
A_HEADS = 12
A_WIDTH = A_HEADS_PER_GROUP * A_HEAD_DIM
B_HEADS = 4
B_NOPE = 128
B_ROPE = 64
B_VDIM = 128
B_Q_LORA = 448
B_KV_LORA = 128
B_Q_BLOCK = 128
B_WIDTH = B_HEADS * B_VDIM
ROPE_THETA = 10000.0
C_HEADS = 4
C_QK_DIM = 64
C_V_DIM = 128
C_WIDTH = C_HEADS * C_V_DIM
C_CONV = 4
C_CHUNK = 64
D_WIDTH = 512
D_GROUP = 16
D_STATE = 64
D_NGROUPS = D_WIDTH // D_GROUP
IN_SPLITS = (
    A_HEADS * A_HEAD_DIM, A_HEADS * A_HEAD_DIM, A_HEADS * A_HEAD_DIM, A_WIDTH,
    B_Q_LORA, B_KV_LORA, B_ROPE, B_WIDTH,
    2 * C_HEADS * C_QK_DIM, C_WIDTH, C_HEADS, C_HEADS, C_WIDTH, C_WIDTH,
    D_WIDTH, D_WIDTH,
    N_BRANCH * D_MODEL,
)
IN_WIDTH = sum(IN_SPLITS)

kernel_name = "hybrid_parallel_gated_mixers"


def _rmsnorm(x, g):
    x32 = x.astype(jnp.float32)
    y = x32 * lax.rsqrt(jnp.mean(x32 * x32, axis=-1, keepdims=True) + EPS)
    return (y * g.astype(jnp.float32)).astype(x.dtype)


def _alibi_slopes(n):
    return 2.0 ** (-8.0 * jnp.arange(1, n + 1, dtype=jnp.float32) / n)


def _dilated_window_attn(q, k, v, window, dil, slopes):
    Bsz, S, H, hd = q.shape
    L = S // dil
    blk = window // dil
    def to_strided(t):
        return t.astype(jnp.float32).reshape(Bsz, L, dil, H, hd).transpose(0, 3, 2, 1, 4)
    qs, ks, vs = to_strided(q), to_strided(k), to_strided(v)
    nb = -(-L // blk)
    pad = nb * blk - L
    qs = jnp.pad(qs, ((0, 0), (0, 0), (0, 0), (0, pad), (0, 0)))
    ks = jnp.pad(ks, ((0, 0), (0, 0), (0, 0), (blk, pad), (0, 0)))
    vs = jnp.pad(vs, ((0, 0), (0, 0), (0, 0), (blk, pad), (0, 0)))
    qb = qs.reshape(Bsz, H, dil, nb, blk, hd)
    kb = ks.reshape(Bsz, H, dil, nb + 1, blk, hd)
    vb = vs.reshape(Bsz, H, dil, nb + 1, blk, hd)
    kw = jnp.concatenate([kb[:, :, :, :-1], kb[:, :, :, 1:]], axis=-2)
    vw = jnp.concatenate([vb[:, :, :, :-1], vb[:, :, :, 1:]], axis=-2)
    s = jnp.einsum('bhrnqd,bhrnkd->bhrnqk', qb, kw) * (hd ** -0.5)
    qi = jnp.arange(blk)[:, None]
    ki = jnp.arange(2 * blk)[None, :]
    delta = qi - ki + blk
    band = (delta >= 0) & (delta <= blk)
    key_abs = jnp.arange(nb)[:, None, None] * blk + ki[None] - blk
    mask = band[None] & (key_abs >= 0)
    bias = -slopes.astype(jnp.float32)[:, None, None] * (delta * dil).astype(jnp.float32)[None]
    s = s + bias[None, :, None, None]
    s = jnp.where(mask, s, -jnp.inf)
    m = jnp.max(s, axis=-1, keepdims=True)
    p = jnp.exp(s - m)
    den = jnp.sum(p, axis=-1, keepdims=True)
    o = jnp.einsum('bhrnqk,bhrnkd->bhrnqd', p, vw) / den
    lse = (m + jnp.log(den))[..., 0]
    o = o.reshape(Bsz, H, dil, nb * blk, hd)[:, :, :, :L].transpose(0, 3, 2, 1, 4).reshape(Bsz, S, H, hd)
    lse = lse.reshape(Bsz, H, dil, nb * blk)[:, :, :, :L].transpose(0, 3, 2, 1).reshape(Bsz, S, H)
    return o, lse


def _branch_dilated(q, k, v, qn_g, kn_g):
    Bsz, S, _ = q.shape
    ng = len(A_GROUPS)
    shp = (Bsz, S, ng, A_HEADS_PER_GROUP, A_HEAD_DIM)
    qh = _rmsnorm(q.reshape(shp), qn_g)
    kh = _rmsnorm(k.reshape(shp), kn_g)
    vh = v.reshape(shp)
    slopes = _alibi_slopes(A_HEADS).reshape(ng, A_HEADS_PER_GROUP)
    outs, lses = [], []
    for g, (window, dil) in enumerate(A_GROUPS):
        o, l = _dilated_window_attn(qh[:, :, g], kh[:, :, g], vh[:, :, g], window, dil, slopes[g])
        outs.append(o)
        lses.append(l)
    o_all = jnp.stack(outs)
    w = jax.nn.softmax(jnp.stack(lses), axis=0)
    out = jnp.sum(w[..., None] * o_all, axis=0)
    return out.reshape(Bsz, S, A_WIDTH).astype(q.dtype)


def _rope(x, cos, sin):
    half = x.shape[-1] // 2
    x1, x2 = x[..., :half], x[..., half:]
    c, s = cos[:, :, None, :], sin[:, :, None, :]
    return jnp.concatenate([x1 * c - x2 * s, x2 * c + x1 * s], axis=-1)


def _branch_mla(c_q, c_kv, k_r, positions, cq_g, ckv_g, w_uq, w_ukv, qn_g, kn_g):
    Bsz, S, _ = c_q.shape
    H = B_HEADS
    q = (_rmsnorm(c_q, cq_g) @ w_uq).reshape(Bsz, S, H, B_NOPE + B_ROPE)
    kv = (_rmsnorm(c_kv, ckv_g) @ w_ukv).reshape(Bsz, S, H, B_NOPE + B_VDIM)
    k_nope, v = kv[..., :B_NOPE], kv[..., B_NOPE:]
    k = jnp.concatenate([k_nope, jnp.broadcast_to(k_r[:, :, None, :], (Bsz, S, H, B_ROPE))], axis=-1)
    q = _rmsnorm(q, qn_g)
    k = _rmsnorm(k, kn_g)
    inv = ROPE_THETA ** (-jnp.arange(0, B_ROPE, 2, dtype=jnp.float32) / B_ROPE)
    ang = positions.astype(jnp.float32)[..., None] * inv
    cos, sin = jnp.cos(ang), jnp.sin(ang)
    q = jnp.concatenate([q[..., :B_NOPE], _rope(q[..., B_NOPE:].astype(jnp.float32), cos, sin).astype(q.dtype)], axis=-1)
    k = jnp.concatenate([k[..., :B_NOPE], _rope(k[..., B_NOPE:].astype(jnp.float32), cos, sin).astype(k.dtype)], axis=-1)
    dq = B_NOPE + B_ROPE
    nb = S // B_Q_BLOCK
    qb = q.reshape(Bsz, nb, B_Q_BLOCK, H, dq).transpose(1, 0, 3, 2, 4)
    kt = k.transpose(0, 2, 1, 3)
    vt = v.transpose(0, 2, 1, 3)
    kpos = jnp.arange(S)
    scale = dq ** -0.5
    def blk_fn(args):
        qblk, i = args
        s = jnp.einsum('bhqd,bhkd->bhqk', qblk, kt).astype(jnp.float32) * scale
        qpos = i * B_Q_BLOCK + jnp.arange(B_Q_BLOCK)
        s = jnp.where(kpos[None, :] <= qpos[:, None], s, -jnp.inf)
        p = jax.nn.softmax(s, axis=-1)
        return jnp.einsum('bhqk,bhkd->bhqd', p.astype(vt.dtype), vt)
    o = lax.map(blk_fn, (qb, jnp.arange(nb)))
    return o.transpose(1, 0, 3, 2, 4).reshape(Bsz, S, B_WIDTH).astype(c_q.dtype)


def _causal_conv(x, w, b):
    K, C = w.shape
    y = lax.conv_general_dilated(x, w[:, None, :], window_strides=(1,), padding=[(K - 1, 0)],
                                 dimension_numbers=('NWC', 'WIO', 'NWC'), feature_group_count=C)
    return y + b


def _branch_mlstm(qk, v, i_pre, f_pre, o_pre, conv_w, conv_b, i_b, f_b):
    Bsz, S, _ = qk.shape
    H, dk, dv, L = C_HEADS, C_QK_DIM, C_V_DIM, C_CHUNK
    qk = jax.nn.silu(_causal_conv(qk, conv_w, conv_b)).astype(jnp.float32)
    q = qk[..., :H * dk].reshape(Bsz, S, H, dk)
    k = qk[..., H * dk:].reshape(Bsz, S, H, dk) * (dk ** -0.5)
    vv = v.astype(jnp.float32).reshape(Bsz, S, H, dv)
    ig = (i_pre + i_b).astype(jnp.float32)
    lf = jax.nn.log_sigmoid((f_pre + f_b).astype(jnp.float32))
    nc = S // L
    def chunks(t):
        t = t.reshape((Bsz, nc, L) + t.shape[2:])
        return jnp.moveaxis(jnp.moveaxis(t, 1, 0), 3, 2)
    qc, kc, vc, igc, lfc = chunks(q), chunks(k), chunks(vv), chunks(ig), chunks(lf)
    tril = jnp.tril(jnp.ones((L, L), dtype=bool))
    def step(carry, xs):
        C, n, m = carry
        qt, kt, vt, it, ft = xs
        b = jnp.cumsum(ft, axis=-1)
        Dm = jnp.where(tril, b[..., :, None] - b[..., None, :] + it[..., None, :], -jnp.inf)
        inter = b + m[..., None]
        mt = jnp.maximum(inter, jnp.max(Dm, axis=-1))
        wD = jnp.exp(Dm - mt[..., None])
        wi = jnp.exp(inter - mt)
        sqk = wD * jnp.einsum('bhtd,bhsd->bhts', qt, kt)
        num = wi[..., None] * jnp.einsum('bhvd,bhtd->bhtv', C, qt) + jnp.einsum('bhts,bhsv->bhtv', sqk, vt)
        den = wi * jnp.einsum('bhd,bhtd->bht', n, qt) + jnp.sum(sqk, axis=-1)
        h = num / jnp.maximum(jnp.abs(den), jnp.exp(-mt))[..., None]
        bL = b[..., -1]
        gs = bL[..., None] - b + it
        m_new = jnp.maximum(bL + m, jnp.max(gs, axis=-1))
        decay = jnp.exp(bL + m - m_new)
        ws = jnp.exp(gs - m_new[..., None])
        C_new = decay[..., None, None] * C + jnp.einsum('bhs,bhsv,bhsd->bhvd', ws, vt, kt)
        n_new = decay[..., None] * n + jnp.einsum('bhs,bhsd->bhd', ws, kt)
        return (C_new, n_new, m_new), h
    init = (jnp.zeros((Bsz, H, dv, dk), jnp.float32), jnp.zeros((Bsz, H, dk), jnp.float32),
            jnp.zeros((Bsz, H), jnp.float32))
    _, hs = lax.scan(step, init, (qc, kc, vc, igc, lfc))
    h = hs.transpose(1, 0, 3, 2, 4).reshape(Bsz, S, C_WIDTH)
    return (jax.nn.sigmoid(o_pre.astype(jnp.float32)) * h).astype(v.dtype)


def _complex_affine_combine(e1, e2):
    a1r, a1i, b1r, b1i = e1
    a2r, a2i, b2r, b2i = e2
    return (a2r * a1r - a2i * a1i, a2r * a1i + a2i * a1r,
            a2r * b1r - a2i * b1i + b2r, a2r * b1i + a2i * b1r + b2i)


def _branch_s5(u, lam_re, lam_im, log_dt, b_re, b_im, c_re, c_im, d_skip, glu_w, glu_b):
    Bsz, S, _ = u.shape
    u32 = u.astype(jnp.float32).reshape(Bsz, S, D_NGROUPS, D_GROUP)
    lr, li = lam_re.astype(jnp.float32), lam_im.astype(jnp.float32)
    dt = jnp.exp(log_dt.astype(jnp.float32))[:, None]
    mag = jnp.exp(lr * dt)
    a_re, a_im = mag * jnp.cos(li * dt), mag * jnp.sin(li * dt)
    den = lr * lr + li * li
    f_re = ((a_re - 1.0) * lr + a_im * li) / den
    f_im = (a_im * lr - (a_re - 1.0) * li) / den
    br, bi = b_re.astype(jnp.float32), b_im.astype(jnp.float32)
    bb_re = f_re[..., None] * br - f_im[..., None] * bi
    bb_im = f_re[..., None] * bi + f_im[..., None] * br
    bu_re = jnp.einsum('bsgc,gpc->bsgp', u32, bb_re)
    bu_im = jnp.einsum('bsgc,gpc->bsgp', u32, bb_im)
    shp = bu_re.shape
    elems = (jnp.broadcast_to(a_re, shp), jnp.broadcast_to(a_im, shp), bu_re, bu_im)
    _, _, x_re, x_im = lax.associative_scan(_complex_affine_combine, elems, axis=1)
    y = (jnp.einsum('bsgp,gcp->bsgc', x_re, c_re.astype(jnp.float32))
         - jnp.einsum('bsgp,gcp->bsgc', x_im, c_im.astype(jnp.float32))
         + d_skip.astype(jnp.float32).reshape(D_NGROUPS, D_GROUP) * u32)
    y = jax.nn.gelu(y.reshape(Bsz, S, D_WIDTH))
    y = y * jax.nn.sigmoid(y @ glu_w.astype(jnp.float32) + glu_b.astype(jnp.float32))
    return y.astype(u.dtype)


def _layer(x, positions, norm_g, w_in, a_qn_g, a_kn_g, b_cq_g, b_ckv_g, b_w_uq, b_w_ukv, b_qn_g, b_kn_g,
           c_conv_w, c_conv_b, c_i_b, c_f_b, d_lam_re, d_lam_im, d_log_dt, d_b_re, d_b_im, d_c_re, d_c_im,
           d_skip, d_glu_w, d_glu_b, w_up, merge_b, w_out):
    Bsz, S, _ = x.shape
    h = _rmsnorm(x, norm_g)
    proj = h @ w_in
    idx = [int(i) for i in np.cumsum(IN_SPLITS)[:-1]]
    (a_q, a_k, a_v, a_z, b_cq, b_ckv, b_kr, b_z, c_qk, c_v, c_i, c_f, c_o, c_z,
     d_u, d_z, gate) = jnp.split(proj, idx, axis=-1)
    ya = _branch_dilated(a_q, a_k, a_v, a_qn_g, a_kn_g) * jax.nn.silu(a_z)
    yb = _branch_mla(b_cq, b_ckv, b_kr, positions, b_cq_g, b_ckv_g, b_w_uq, b_w_ukv, b_qn_g, b_kn_g) * jax.nn.silu(b_z)
    yc = _branch_mlstm(c_qk, c_v, c_i, c_f, c_o, c_conv_w, c_conv_b, c_i_b, c_f_b) * jax.nn.silu(c_z)
    yd = _branch_s5(d_u, d_lam_re, d_lam_im, d_log_dt, d_b_re, d_b_im, d_c_re, d_c_im,
                    d_skip, d_glu_w, d_glu_b) * jax.nn.silu(d_z)
    ys = jnp.stack([ya, yb, yc, yd], axis=2)
    up = jnp.einsum('bsnw,nwd->bsnd', ys, w_up)
    gates = jax.nn.sigmoid((gate + merge_b).astype(jnp.float32)).reshape(Bsz, S, N_BRANCH, D_MODEL)
    merged = jnp.sum(gates * up.astype(jnp.float32), axis=2).astype(x.dtype)
    return x + merged @ w_out


def setup_inputs(seed: int = 0) -> dict:
    key = jax.random.key(seed)
    ks = jax.random.split(key, 32)
    nrm = jax.random.normal
    G, P = D_NGROUPS, D_STATE
    f32 = jnp.float32
    x = nrm(ks[0], (BATCH, SEQ, D_MODEL), f32)
    positions = jnp.broadcast_to(jnp.arange(SEQ, dtype=jnp.int32), (BATCH, SEQ))
    norm_g = 1.0 + 0.02 * nrm(ks[1], (DEPTH, D_MODEL), f32)
    w_in = nrm(ks[2], (DEPTH, D_MODEL, IN_WIDTH), f32) * D_MODEL ** -0.5
    a_qn_g = 1.0 + 0.02 * nrm(ks[3], (DEPTH, A_HEAD_DIM), f32)
    a_kn_g = 1.0 + 0.02 * nrm(ks[4], (DEPTH, A_HEAD_DIM), f32)
    b_cq_g = 1.0 + 0.02 * nrm(ks[5], (DEPTH, B_Q_LORA), f32)
    b_ckv_g = 1.0 + 0.02 * nrm(ks[6], (DEPTH, B_KV_LORA), f32)
    b_w_uq = nrm(ks[7], (DEPTH, B_Q_LORA, B_HEADS * (B_NOPE + B_ROPE)), f32) * B_Q_LORA ** -0.5
    b_w_ukv = nrm(ks[8], (DEPTH, B_KV_LORA, B_HEADS * (B_NOPE + B_VDIM)), f32) * B_KV_LORA ** -0.5
    b_qn_g = 1.0 + 0.02 * nrm(ks[9], (DEPTH, B_NOPE + B_ROPE), f32)
    b_kn_g = 1.0 + 0.02 * nrm(ks[10], (DEPTH, B_NOPE + B_ROPE), f32)
    c_conv_w = nrm(ks[11], (DEPTH, C_CONV, 2 * C_HEADS * C_QK_DIM), f32) * C_CONV ** -0.5
    c_conv_b = 0.01 * nrm(ks[12], (DEPTH, 2 * C_HEADS * C_QK_DIM), f32)
    c_i_b = -1.0 + 0.1 * nrm(ks[13], (DEPTH, C_HEADS), f32)
    c_f_b = jnp.linspace(3.0, 6.0, C_HEADS, dtype=f32)[None] + 0.1 * nrm(ks[14], (DEPTH, C_HEADS), f32)
    d_lam_re = -0.5 + 0.01 * nrm(ks[15], (DEPTH, G, P), f32)
    d_lam_im = math.pi * jnp.arange(P, dtype=f32)[None, None] + 0.01 * nrm(ks[16], (DEPTH, G, P), f32)
    d_log_dt = jax.random.uniform(ks[17], (DEPTH, G), f32, math.log(1e-3), math.log(1e-1))
    b_scale = (2.0 * D_GROUP) ** -0.5
    d_b_re = nrm(ks[18], (DEPTH, G, P, D_GROUP), f32) * b_scale
    d_b_im = nrm(ks[19], (DEPTH, G, P, D_GROUP), f32) * b_scale
    c_scale = (2.0 * P) ** -0.5
    d_c_re = nrm(ks[20], (DEPTH, G, D_GROUP, P), f32) * c_scale
    d_c_im = nrm(ks[21], (DEPTH, G, D_GROUP, P), f32) * c_scale
    d_skip = 1.0 + 0.1 * nrm(ks[22], (DEPTH, D_WIDTH), f32)
    d_glu_w = nrm(ks[23], (DEPTH, D_WIDTH, D_WIDTH), f32) * D_WIDTH ** -0.5
    d_glu_b = 0.01 * nrm(ks[24], (DEPTH, D_WIDTH), f32)
    w_up = nrm(ks[25], (DEPTH, N_BRANCH, BRANCH_WIDTH, D_MODEL), f32) * BRANCH_WIDTH ** -0.5
    merge_b = 0.01 * nrm(ks[26], (DEPTH, N_BRANCH * D_MODEL), f32)
    w_out = nrm(ks[27], (DEPTH, D_MODEL, D_MODEL), f32) * D_MODEL ** -0.5
    return {"x": x, "positions": positions, "norm_g": norm_g, "w_in": w_in,
            "a_qn_g": a_qn_g, "a_kn_g": a_kn_g, "b_cq_g": b_cq_g, "b_ckv_g": b_ckv_g,
            "b_w_uq": b_w_uq, "b_w_ukv": b_w_ukv, "b_qn_g": b_qn_g, "b_kn_g": b_kn_g,
            "c_conv_w": c_conv_w, "c_conv_b": c_conv_b, "c_i_b": c_i_b, "c_f_b": c_f_b,
            "d_lam_re": d_lam_re, "d_lam_im": d_lam_im, "d_log_dt": d_log_dt,
            "d_b_re": d_b_re, "d_b_im": d_b_im, "d_c_re": d_c_re, "d_c_im": d_c_im,
            "d_skip": d_skip, "d_glu_w": d_glu_w, "d_glu_b": d_glu_b,
            "w_up": w_up, "merge_b": merge_b, "w_out": w_out}


def reference(x, positions, norm_g, w_in, a_qn_g, a_kn_g, b_cq_g, b_ckv_g, b_w_uq, b_w_ukv, b_qn_g, b_kn_g,
              c_conv_w, c_conv_b, c_i_b, c_f_b, d_lam_re, d_lam_im, d_log_dt, d_b_re, d_b_im, d_c_re, d_c_im,
              d_skip, d_glu_w, d_glu_b, w_up, merge_b, w_out):
    for l in range(DEPTH):
        x = _layer(x, positions, norm_g[l], w_in[l], a_qn_g[l], a_kn_g[l], b_cq_g[l], b_ckv_g[l],
                   b_w_uq[l], b_w_ukv[l], b_qn_g[l], b_kn_g[l], c_conv_w[l], c_conv_b[l], c_i_b[l], c_f_b[l],
                   d_lam_re[l], d_lam_im[l], d_log_dt[l], d_b_re[l], d_b_im[l], d_c_re[l], d_c_im[l],
                   d_skip[l], d_glu_w[l], d_glu_b[l], w_up[l], merge_b[l], w_out[l])
    return x
```

```cpp
#include <hip/hip_runtime.h>
#include <hip/hip_cooperative_groups.h>
#include <cstdio>
#include <type_traits>
namespace cg = cooperative_groups;

#define LAS __attribute__((address_space(3)))
typedef unsigned short bf16_t;
typedef short bf16x8 __attribute__((ext_vector_type(8)));
typedef float f32x4 __attribute__((ext_vector_type(4)));
typedef unsigned u32x4 __attribute__((ext_vector_type(4)));
typedef unsigned u32x2 __attribute__((ext_vector_type(2)));

constexpr int SEQ = 8192, DM = 2048, NIN = 17544, NP = 17664, NG0 = 9352, GATE0 = 9472, DEPTH = 4;
constexpr int O_AQ = 0, O_AK = 1536, O_AV = 3072, O_AZ = 4608, O_BCQ = 5120, O_BCKV = 5568, O_BKR = 5696, O_BZ = 5760, O_CQK = 6272,
              O_CV = 6784, O_CI = 7296, O_CF = 7300, O_CO = 7304, O_CZ = 7816, O_DU = 8328, O_DZ = 8840;
constexpr float EPS = 1e-6f;
constexpr int LDS_BYTES = 144 * 1024;
#define REP_W 1
#define REP_P1 1
#define REP_SYNC 0
#define REP_P9 1
#define REP_A 1
#define REP_D1 1
#define REP_D3 1
#define REP_C3 1
#define REP_P2 1
#define REP_P3 1
#define REP_P4 1
#define REP_P5 1
#define REP_P6 1
#define REP_P7 1
#define REP_P8 1

constexpr size_t al(size_t x) { return (x + 255) & ~(size_t)255; }
constexpr size_t SZ_WIN = (size_t)NP * DM * 2, SZ_WSQ = (size_t)DM * DM * 2, SZ_WUQ = (size_t)768 * 512 * 2, SZ_WUKV = (size_t)1024 * 256 * 2, SZ_WGLU = (size_t)512 * 512 * 2;
constexpr size_t W_WIN = 0;
constexpr size_t W_WUP = W_WIN + DEPTH * SZ_WIN;
constexpr size_t W_WOUT = W_WUP + DEPTH * SZ_WSQ;
constexpr size_t W_WUQ = W_WOUT + DEPTH * SZ_WSQ;
constexpr size_t W_WUKV = W_WUQ + DEPTH * SZ_WUQ;
constexpr size_t W_WGLU = W_WUKV + DEPTH * SZ_WUKV;
constexpr size_t W_H = W_WGLU + DEPTH * SZ_WGLU;
constexpr size_t W_PROJ = W_H + (size_t)SEQ * DM * 2;
constexpr size_t W_QA = W_PROJ + (size_t)SEQ * NP * 2;
constexpr size_t W_KA = W_QA + (size_t)12 * SEQ * 128 * 2;
constexpr size_t W_VAT = W_KA + (size_t)12 * SEQ * 128 * 2;
constexpr size_t W_CQN = W_VAT + (size_t)12 * SEQ * 128 * 2;
constexpr size_t W_CKVN = W_CQN + (size_t)SEQ * 512 * 2;
constexpr size_t W_QRAW = W_CKVN + (size_t)SEQ * 256 * 2;
constexpr size_t W_KVRAW = W_QRAW + (size_t)SEQ * 768 * 2;
constexpr size_t W_QB = W_KVRAW + (size_t)SEQ * 1024 * 2;
constexpr size_t W_KB = W_QB + (size_t)4 * SEQ * 192 * 2;
constexpr size_t W_VBT = W_KB + (size_t)4 * SEQ * 192 * 2;
constexpr size_t W_OA = W_VBT + (size_t)4 * 128 * SEQ * 2;
constexpr size_t W_LSEA = W_OA + (size_t)3 * SEQ * 512 * 4;
constexpr size_t W_OB = W_LSEA + (size_t)3 * SEQ * 4 * 4;
constexpr size_t W_LSEB = W_OB + (size_t)2 * SEQ * 512 * 4;
constexpr size_t W_CLOC = W_LSEB + (size_t)2 * SEQ * 4 * 4;
constexpr size_t W_CST = W_CLOC + (size_t)512 * 8192 * 4;
constexpr size_t W_NLOC = W_CST + (size_t)512 * 8192 * 4;
constexpr size_t W_NST = W_NLOC + (size_t)512 * 64 * 4;
constexpr size_t W_META = W_NST + (size_t)512 * 64 * 4;
constexpr size_t W_MST = W_META + al(512 * 2 * 4);
constexpr size_t W_XEND = W_MST + al(512 * 4);
constexpr size_t W_XST = W_XEND + (size_t)128 * 2048 * 2 * 4;
constexpr size_t W_YD = W_XST + (size_t)128 * 2048 * 2 * 4;
constexpr size_t W_YS = W_YD + (size_t)SEQ * 512 * 2;
constexpr size_t W_MERGED = W_YS + (size_t)SEQ * DM * 2;
constexpr size_t W_BAR = W_MERGED + (size_t)SEQ * DM * 2;
constexpr size_t W_END = W_BAR + 16384;

struct Params { const float* in[29]; float* out; unsigned char* ws; };
typedef const Params __attribute__((address_space(4))) * KP;
__device__ __forceinline__ KP fresh_params() { KP p = (KP)__builtin_amdgcn_kernarg_segment_ptr(); asm volatile("" : "+s"(p)); return p; }

__device__ __forceinline__ float bflo(unsigned u) { return __uint_as_float(u << 16); }
__device__ __forceinline__ float bfhi(unsigned u) { return __uint_as_float(u & 0xffff0000u); }
__device__ __forceinline__ float bf2f(bf16_t b) { return __uint_as_float(((unsigned)b) << 16); }
__device__ __forceinline__ unsigned cvt_pk_bf16(float lo, float hi) { unsigned r; asm volatile("s_nop 0\n\tv_cvt_pk_bf16_f32 %0, %1, %2" : "=v"(r) : "v"(lo), "v"(hi)); return r; }
__device__ __forceinline__ bf16_t f2bf(float f) { return (bf16_t)(cvt_pk_bf16(f, 0.f) & 0xffffu); }
__device__ __forceinline__ void ld8(const bf16_t* p, float (&v)[8]) {
    const u32x4 u = *(const u32x4*)p;
    v[0] = bflo(u.x); v[1] = bfhi(u.x); v[2] = bflo(u.y); v[3] = bfhi(u.y); v[4] = bflo(u.z); v[5] = bfhi(u.z); v[6] = bflo(u.w); v[7] = bfhi(u.w);
}
__device__ __forceinline__ void st8(bf16_t* p, const float (&v)[8]) {
    u32x4 u; u.x = cvt_pk_bf16(v[0], v[1]); u.y = cvt_pk_bf16(v[2], v[3]); u.z = cvt_pk_bf16(v[4], v[5]); u.w = cvt_pk_bf16(v[6], v[7]);
    *(u32x4*)p = u;
}
__device__ __forceinline__ float sigmoidf_(float x) { return __builtin_amdgcn_rcpf(1.f + __expf(-x)); }
__device__ __forceinline__ float siluf_(float x) { return x * sigmoidf_(x); }
__device__ __forceinline__ float wave_sum(float v) {
#pragma unroll
    for (int o = 1; o < 64; o <<= 1) v += __shfl_xor(v, o);
    return v;
}
__device__ __forceinline__ float wave_max(float v) {
#pragma unroll
    for (int o = 1; o < 64; o <<= 1) v = fmaxf(v, __shfl_xor(v, o));
    return v;
}
__device__ __forceinline__ int fresh_tid() { int t = threadIdx.x; asm volatile("" : "+v"(t)); return t; }
template <int CTRL> __device__ __forceinline__ float dppf(float v) { return __int_as_float(__builtin_amdgcn_update_dpp(0, __float_as_int(v), CTRL, 0xf, 0xf, true)); }
__device__ __forceinline__ float row16_max(float v) { v = fmaxf(v, dppf<0x128>(v)); v = fmaxf(v, dppf<0x124>(v)); v = fmaxf(v, dppf<0x122>(v)); v = fmaxf(v, dppf<0x121>(v)); return v; }
__device__ __forceinline__ float row16_sum(float v) { v += dppf<0x128>(v); v += dppf<0x124>(v); v += dppf<0x122>(v); v += dppf<0x121>(v); return v; }
#define LDS_FENCE() asm volatile("s_waitcnt lgkmcnt(0)" ::: "memory")

namespace pg8 {
constexpr int BM = 256, BK = 64, HALF = 128, HTB = HALF * BK * 2, STAGE_BYTES = 8 * HTB, NXCD = 8, WGM = 4;
__device__ __forceinline__ int lds_byte(int r, int c) { const int st = (r >> 4) * 2 + (c >> 5), rr = r & 15, cc = c & 31, ob = rr * 64 + cc * 2; return st * 1024 + (ob ^ (((ob >> 9) & 1) << 5)); }
__device__ __forceinline__ void stage_rc(int b, int& R, int& C) { const int st = b / 1024, sb = b % 1024, swz = sb ^ (((sb >> 9) & 1) << 5); R = (st >> 1) * 16 + swz / 64; C = (st & 1) * 32 + (swz % 64) / 2; }
__device__ __forceinline__ int perm32(int rho) { const int n = rho >> 4, i = rho & 15; return 8 * (i >> 2) + 4 * n + (i & 3); }
struct Unit { int pm, pn; };
struct Gemm { const bf16_t* A; const bf16_t* Bt; int M, N, K; };
struct StaticOrder {
    int nM, nN, nwg, G, c;
    __device__ void init(int M, int N, int G_, int c_) { nM = M / BM; nN = N / BM; nwg = nM * nN; G = G_; c = c_; }
    __device__ bool next(int i, Unit& u) const {
        const long L = (long)i * G + c; if (L >= nwg) return false;
        int wgid = (int)L; { const int q = nwg / NXCD, r = nwg % NXCD, xcd = wgid % NXCD, off = wgid / NXCD; wgid = (xcd < r ? xcd * (q + 1) : r * (q + 1) + (xcd - r) * q) + off; }
        const int nig = WGM * nN, gid = wgid / nig, fm = gid * WGM, gsz = (nM - fm) < WGM ? (nM - fm) : WGM;
        u.pm = fm + ((wgid % nig) % gsz); u.pn = (wgid % nig) / gsz; return true;
    }
};

template <class Epi>
__device__ __forceinline__ void gemm_phase(LAS unsigned char* lds, const Gemm g, const StaticOrder& S, const Epi& E) {
    const int tid = fresh_tid(), wid = __builtin_amdgcn_readfirstlane(tid >> 6), lane = tid & 63, wr = wid >> 2, wc = wid & 3, fr = lane & 15, fq = lane >> 4;
    const int K = g.K, nt = K / BK;
    unsigned voffA[2], voffB[2];
#pragma unroll
    for (int i = 0; i < 2; ++i) { int R, C; stage_rc(tid * 16 + i * 8192, R, C); const int Rb = Epi::PERM ? ((R & ~31) + perm32(R & 31)) : R;
        voffA[i] = (unsigned)(R * K + C) * 2u; voffB[i] = (unsigned)(Rb * K + C) * 2u; }
    const size_t kstep = (size_t)(BK * 2);
    const size_t hstep = (size_t)HALF * K * 2;
    const size_t tstep = 2 * hstep;
    const unsigned ldsw = (unsigned)wid * 1024u;
    const int aoff = lds_byte(wr * 64 + fr, fq * 8), boff = lds_byte(wc * 32 + fr, fq * 8);
#define PG8_SA(b, h) (((b) * 2 + (h)) * HTB)
#define PG8_SB(b, h) ((4 + (b) * 2 + (h)) * HTB)
#define PG8_STAGE_(bufoff, gbase, voff) do { _Pragma("unroll") for (int _i = 0; _i < 2; ++_i) \
        __builtin_amdgcn_global_load_lds((const unsigned*)((const char*)(gbase) + (voff)[_i]), (LAS unsigned*)(lds + (bufoff) + ldsw + _i * 8192), 16, 0, 0); } while (0)
#define PG8_STAGE(bufoff, gbase) PG8_STAGE_(bufoff, gbase, voffA)
#define PG8_STAGEB(bufoff, gbase) PG8_STAGE_(bufoff, gbase, voffB)
#define PG8_LDA(dst, b, h) do { _Pragma("unroll") for (int m = 0; m < 4; ++m) _Pragma("unroll") for (int k = 0; k < 2; ++k) dst[m][k] = *(const LAS bf16x8*)(lds + PG8_SA(b, h) + aoff + m * 2048 + k * 1024); } while (0)
#define PG8_LDB(dst, b, h) do { _Pragma("unroll") for (int n = 0; n < 2; ++n) _Pragma("unroll") for (int k = 0; k < 2; ++k) dst[n][k] = *(const LAS bf16x8*)(lds + PG8_SB(b, h) + boff + n * 2048 + k * 1024); } while (0)
#define PG8_MMA(ai, bj, At, Bt) do { __builtin_amdgcn_s_setprio(1); _Pragma("unroll") for (int m = 0; m < 4; ++m) _Pragma("unroll") for (int n = 0; n < 2; ++n) _Pragma("unroll") for (int k = 0; k < 2; ++k) \
        acc[ai][bj][m][n] = __builtin_amdgcn_mfma_f32_16x16x32_bf16(Bt[n][k], At[m][k], acc[ai][bj][m][n], 0, 0, 0); __builtin_amdgcn_s_setprio(0); } while (0)
#define PG8_WAIT_V(n) asm volatile("s_waitcnt vmcnt(" #n ")" ::: "memory")
#define PG8_WAIT_L(n) asm volatile("s_waitcnt lgkmcnt(" #n ")" ::: "memory")
#define PG8_BAR __builtin_amdgcn_s_barrier()
#define PG8_SCHED __builtin_amdgcn_sched_barrier(0)
    Unit cur, nxt; int ui = 0;
    if (!S.next(0, cur)) return;
    f32x4 acc[2][2][4][2];
#pragma unroll
    for (int a = 0; a < 2; ++a)
#pragma unroll
        for (int b = 0; b < 2; ++b)
#pragma unroll
            for (int m = 0; m < 4; ++m)
#pragma unroll
                for (int n = 0; n < 2; ++n) acc[a][b][m][n] = (f32x4){0.f, 0.f, 0.f, 0.f};
    bf16x8 At[4][2], B0[2][2], B1[2][2];
    const char* cA = (const char*)g.A + (size_t)cur.pm * tstep; const char* cB = (const char*)g.Bt + (size_t)cur.pn * tstep;
    PG8_STAGEB(PG8_SB(0, 0), cB); PG8_STAGE(PG8_SA(0, 0), cA); PG8_STAGEB(PG8_SB(0, 1), cB + hstep); PG8_STAGE(PG8_SA(0, 1), cA + hstep);
    if (wr == 1) PG8_BAR;
    PG8_WAIT_V(4); PG8_BAR;
    PG8_STAGEB(PG8_SB(1, 0), cB + kstep); PG8_STAGE(PG8_SA(1, 0), cA + kstep); PG8_STAGEB(PG8_SB(1, 1), cB + hstep + kstep);
    PG8_WAIT_V(6); PG8_BAR;
    for (;;) {
        const bool has_next = S.next(ui + 1, nxt);
        const char* nA = has_next ? (const char*)g.A + (size_t)nxt.pm * tstep : cA; const char* nB = has_next ? (const char*)g.Bt + (size_t)nxt.pn * tstep : cB;
        for (int t = 0; t < nt; t += 2) {
            const bool last = (t == nt - 2);
            const char* a1 = cA + (size_t)(t + 1) * kstep;
            const char* a2 = last ? nA : cA + (size_t)(t + 2) * kstep; const char* b2 = last ? nB : cB + (size_t)(t + 2) * kstep;
            const char* a3 = a2 + kstep; const char* b3 = b2 + kstep;
            if constexpr (Epi::RESCALE) { if (t != 0 && (t & 7) == 0) { const int t2 = fresh_tid(); const int w2 = __builtin_amdgcn_readfirstlane(t2 >> 6); E.rescale(acc, cur, t >> 3, w2 >> 2, w2 & 3, t2 & 15, (t2 >> 4) & 3); } }
            PG8_LDB(B0, 0, 0); PG8_SCHED; PG8_LDA(At, 0, 0); PG8_STAGE(PG8_SA(1, 1), a1 + hstep);
            PG8_WAIT_L(8); PG8_BAR; PG8_WAIT_L(0); PG8_MMA(0, 0, At, B0); PG8_BAR; PG8_SCHED;
            PG8_LDB(B1, 0, 1); PG8_STAGEB(PG8_SB(0, 0), b2);
            PG8_BAR; PG8_WAIT_L(0); PG8_MMA(0, 1, At, B1); PG8_BAR;
            PG8_LDA(At, 0, 1); PG8_STAGE(PG8_SA(0, 0), a2);
            PG8_BAR; PG8_WAIT_L(0); PG8_MMA(1, 0, At, B0); PG8_BAR; PG8_SCHED;
            PG8_STAGEB(PG8_SB(0, 1), b2 + hstep);
            PG8_WAIT_V(6); PG8_BAR; PG8_MMA(1, 1, At, B1); PG8_BAR;
            PG8_LDB(B0, 1, 0); PG8_SCHED; PG8_LDA(At, 1, 0); PG8_STAGE(PG8_SA(0, 1), a2 + hstep);
            PG8_WAIT_L(8); PG8_BAR; PG8_WAIT_L(0); PG8_MMA(0, 0, At, B0); PG8_BAR; PG8_SCHED;
            PG8_LDB(B1, 1, 1); PG8_STAGEB(PG8_SB(1, 0), b3);
            PG8_BAR; PG8_WAIT_L(0); PG8_MMA(0, 1, At, B1); PG8_BAR;
            PG8_LDA(At, 1, 1); PG8_STAGE(PG8_SA(1, 0), a3);
            PG8_BAR; PG8_WAIT_L(0); PG8_MMA(1, 0, At, B0); PG8_BAR; PG8_SCHED;
            PG8_STAGEB(PG8_SB(1, 1), b3 + hstep);
            PG8_WAIT_V(6); PG8_BAR; PG8_MMA(1, 1, At, B1); PG8_BAR;
        }
        { const int t2 = fresh_tid(); const int w2 = __builtin_amdgcn_readfirstlane(t2 >> 6); E(acc, cur, w2 >> 2, w2 & 3, t2 & 15, (t2 >> 4) & 3); }
        if (!has_next) break;
#pragma unroll
        for (int a = 0; a < 2; ++a)
#pragma unroll
            for (int b = 0; b < 2; ++b)
#pragma unroll
                for (int m = 0; m < 4; ++m)
#pragma unroll
                    for (int n = 0; n < 2; ++n) acc[a][b][m][n] = (f32x4){0.f, 0.f, 0.f, 0.f};
        cur = nxt; cA = nA; cB = nB; ++ui;
    }
    PG8_WAIT_V(0);
    if (wr == 0) PG8_BAR;
    PG8_BAR;
#undef PG8_SA
#undef PG8_SB
#undef PG8_STAGE
#undef PG8_STAGEB
#undef PG8_STAGE_
#undef PG8_LDA
#undef PG8_LDB
#undef PG8_MMA
#undef PG8_WAIT_V
#undef PG8_WAIT_L
#undef PG8_BAR
#undef PG8_SCHED
}
}
using pg8::Unit;
typedef f32x4 AccT[2][2][4][2];

struct EpiProj {
    static constexpr bool RESCALE = false, PERM = true;
    bf16_t* O; const float* mb;
    __device__ __forceinline__ void operator()(AccT& acc, const Unit& u, int wr, int wc, int fr, int fq) const {
        int row0 = u.pm * 256 + wr * 64 + fr, col0 = u.pn * 256 + wc * 32 + 8 * fq;
        asm volatile("" : "+v"(row0), "+v"(col0));
        const bool gate = u.pn >= 37;
        f32x4 bv[2][2];
#pragma unroll
        for (int bj = 0; bj < 2; ++bj)
#pragma unroll
            for (int n = 0; n < 2; ++n) bv[bj][n] = gate ? *(const f32x4*)(mb + (col0 - GATE0) + bj * 128 + n * 4) : (f32x4){0.f, 0.f, 0.f, 0.f};
#pragma unroll
        for (int ai = 0; ai < 2; ++ai)
#pragma unroll
            for (int m = 0; m < 4; ++m) { bf16_t* rowp = O + (size_t)(row0 + ai * 128 + m * 16) * NP + col0;
#pragma unroll
                for (int bj = 0; bj < 2; ++bj) { f32x4 v0 = acc[ai][bj][m][0], v1 = acc[ai][bj][m][1];
                    if (gate) { v0 = v0 + bv[bj][0]; v1 = v1 + bv[bj][1];
                        v0[0] = sigmoidf_(v0[0]); v0[1] = sigmoidf_(v0[1]); v0[2] = sigmoidf_(v0[2]); v0[3] = sigmoidf_(v0[3]);
                        v1[0] = sigmoidf_(v1[0]); v1[1] = sigmoidf_(v1[1]); v1[2] = sigmoidf_(v1[2]); v1[3] = sigmoidf_(v1[3]); }
                    u32x4 w; w.x = cvt_pk_bf16(v0[0], v0[1]); w.y = cvt_pk_bf16(v0[2], v0[3]); w.z = cvt_pk_bf16(v1[0], v1[1]); w.w = cvt_pk_bf16(v1[2], v1[3]);
                    *(u32x4*)(rowp + bj * 128) = w; } }
    }
};
struct EpiBf16 {
    static constexpr bool RESCALE = false, PERM = true;
    bf16_t* O; int ldc;
    __device__ __forceinline__ void operator()(AccT& acc, const Unit& u, int wr, int wc, int fr, int fq) const {
        int row0 = u.pm * 256 + wr * 64 + fr, col0 = u.pn * 256 + wc * 32 + 8 * fq;
        asm volatile("" : "+v"(row0), "+v"(col0));
#pragma unroll
        for (int ai = 0; ai < 2; ++ai)
#pragma unroll
            for (int m = 0; m < 4; ++m) { bf16_t* rowp = O + (size_t)(row0 + ai * 128 + m * 16) * ldc + col0;
#pragma unroll
                for (int bj = 0; bj < 2; ++bj) { const f32x4 v0 = acc[ai][bj][m][0], v1 = acc[ai][bj][m][1];
                    u32x4 w; w.x = cvt_pk_bf16(v0[0], v0[1]); w.y = cvt_pk_bf16(v0[2], v0[3]); w.z = cvt_pk_bf16(v1[0], v1[1]); w.w = cvt_pk_bf16(v1[2], v1[3]);
                    *(u32x4*)(rowp + bj * 128) = w; } }
    }
};
struct EpiKV {
    static constexpr bool RESCALE = false, PERM = true;
    bf16_t* O; bf16_t* VT;
    __device__ __forceinline__ void operator()(AccT& acc, const Unit& u, int wr, int wc, int fr, int fq) const {
        int row0 = u.pm * 256 + wr * 64 + fr, cl = wc * 32 + 8 * fq;
        asm volatile("" : "+v"(row0), "+v"(cl));
#pragma unroll
        for (int ai = 0; ai < 2; ++ai)
#pragma unroll
            for (int m = 0; m < 4; ++m) { const int row = row0 + ai * 128 + m * 16;
                { const f32x4 v0 = acc[ai][0][m][0], v1 = acc[ai][0][m][1];
                  u32x4 w; w.x = cvt_pk_bf16(v0[0], v0[1]); w.y = cvt_pk_bf16(v0[2], v0[3]); w.z = cvt_pk_bf16(v1[0], v1[1]); w.w = cvt_pk_bf16(v1[2], v1[3]);
                  *(u32x4*)(O + (size_t)row * 1024 + u.pn * 256 + cl) = w; }
#pragma unroll
                for (int n = 0; n < 2; ++n) { const f32x4 v = acc[ai][1][m][n];
                    const unsigned w0 = cvt_pk_bf16(v[0], v[1]), w1 = cvt_pk_bf16(v[2], v[3]);
                    bf16_t* vp = VT + (size_t)(u.pn * 128 + cl + n * 4) * SEQ + row;
                    vp[0] = (bf16_t)(w0 & 0xffffu); vp[SEQ] = (bf16_t)(w0 >> 16); vp[2 * SEQ] = (bf16_t)(w1 & 0xffffu); vp[3 * SEQ] = (bf16_t)(w1 >> 16); } }
    }
};
struct EpiGlu {
    static constexpr bool RESCALE = false, PERM = true;
    const bf16_t* yd; const bf16_t* proj; const float* gb; bf16_t* ys;
    __device__ __forceinline__ void operator()(AccT& acc, const Unit& u, int wr, int wc, int fr, int fq) const {
        int row0 = u.pm * 256 + wr * 64 + fr, col0 = u.pn * 256 + wc * 32 + 8 * fq;
        asm volatile("" : "+v"(row0), "+v"(col0));
#pragma unroll
        for (int ai = 0; ai < 2; ++ai)
#pragma unroll
            for (int m = 0; m < 4; ++m) { const size_t row = (size_t)(row0 + ai * 128 + m * 16);
#pragma unroll
                for (int bj = 0; bj < 2; ++bj) { const int c = col0 + bj * 128;
                    float y8[8], z8[8], o8[8]; ld8(yd + row * 512 + c, y8); ld8(proj + row * NP + O_DZ + c, z8);
                    const f32x4 b0 = *(const f32x4*)(gb + c), b1 = *(const f32x4*)(gb + c + 4);
#pragma unroll
                    for (int e = 0; e < 4; ++e) { o8[e] = y8[e] * sigmoidf_(acc[ai][bj][m][0][e] + b0[e]) * siluf_(z8[e]); o8[4 + e] = y8[4 + e] * sigmoidf_(acc[ai][bj][m][1][e] + b1[e]) * siluf_(z8[4 + e]); }
                    st8(ys + row * DM + 1536 + c, o8); } }
    }
};
struct EpiUp {
    static constexpr bool RESCALE = true, PERM = true;
    const bf16_t* proj; bf16_t* O;
    __device__ __forceinline__ void rescale(AccT& acc, const Unit& u, int k, int wr, int wc, int fr, int fq) const {
        int row0 = u.pm * 256 + wr * 64 + fr, col0 = u.pn * 256 + wc * 32 + 8 * fq;
        asm volatile("" : "+v"(row0), "+v"(col0));
#pragma unroll
        for (int ai = 0; ai < 2; ++ai)
#pragma unroll
            for (int m = 0; m < 4; ++m) { const bf16_t* gp = proj + (size_t)(row0 + ai * 128 + m * 16) * NP + GATE0 + (k - 1) * DM + col0;
#pragma unroll
                for (int bj = 0; bj < 2; ++bj) { float ga[8], gb[8]; ld8(gp + bj * 128, ga); ld8(gp + DM + bj * 128, gb);
                    f32x4 r0, r1;
#pragma unroll
                    for (int e = 0; e < 4; ++e) { r0[e] = ga[e] * __builtin_amdgcn_rcpf(fmaxf(gb[e], 1e-30f)); r1[e] = ga[4 + e] * __builtin_amdgcn_rcpf(fmaxf(gb[4 + e], 1e-30f)); }
                    acc[ai][bj][m][0] = acc[ai][bj][m][0] * r0; acc[ai][bj][m][1] = acc[ai][bj][m][1] * r1; }
                asm volatile("" ::: "memory"); }
    }
    __device__ __forceinline__ void operator()(AccT& acc, const Unit& u, int wr, int wc, int fr, int fq) const {
        int row0 = u.pm * 256 + wr * 64 + fr, col0 = u.pn * 256 + wc * 32 + 8 * fq;
        asm volatile("" : "+v"(row0), "+v"(col0));
#pragma unroll
        for (int ai = 0; ai < 2; ++ai)
#pragma unroll
            for (int m = 0; m < 4; ++m) { const size_t row = (size_t)(row0 + ai * 128 + m * 16); const bf16_t* gp = proj + row * NP + GATE0 + 3 * DM + col0;
#pragma unroll
                for (int bj = 0; bj < 2; ++bj) { float g8[8], o8[8]; ld8(gp + bj * 128, g8);
#pragma unroll
                    for (int e = 0; e < 4; ++e) { o8[e] = acc[ai][bj][m][0][e] * g8[e]; o8[4 + e] = acc[ai][bj][m][1][e] * g8[4 + e]; }
                    st8(O + row * DM + col0 + bj * 128, o8); }
                asm volatile("" ::: "memory"); }
    }
};
struct EpiOut {
    static constexpr bool RESCALE = false, PERM = true;
    const float* xin; float* out;
    __device__ __forceinline__ void operator()(AccT& acc, const Unit& u, int wr, int wc, int fr, int fq) const {
        int row0 = u.pm * 256 + wr * 64 + fr, col0 = u.pn * 256 + wc * 32 + 8 * fq;
        asm volatile("" : "+v"(row0), "+v"(col0));
#pragma unroll
        for (int ai = 0; ai < 2; ++ai)
#pragma unroll
            for (int m = 0; m < 4; ++m) { const size_t off = (size_t)(row0 + ai * 128 + m * 16) * DM + col0;
#pragma unroll
                for (int bj = 0; bj < 2; ++bj) { const f32x4 x0 = *(const f32x4*)(xin + off + bj * 128), x1 = *(const f32x4*)(xin + off + bj * 128 + 4);
                    *(f32x4*)(out + off + bj * 128) = x0 + acc[ai][bj][m][0]; *(f32x4*)(out + off + bj * 128 + 4) = x1 + acc[ai][bj][m][1]; } }
    }
};

__device__ __forceinline__ void tr_item(const float* W, int K, int N, bf16_t* WT, int ldk, int split, int shift, LAS float* scr, int item, int lane) {
    const int nblk = (N + 63) >> 6, kb = item / nblk, nb = item - kb * nblk, k0 = 64 * kb, n0 = 64 * nb;
    const int c4 = (lane & 15) * 4, rq = lane >> 4;
    const bool okc = n0 + c4 < N;
    f32x4 tv[16];
#pragma unroll
    for (int i = 0; i < 16; ++i) { const int kk = i * 4 + rq; tv[i] = okc ? *(const f32x4*)(W + (size_t)(k0 + kk) * N + n0 + c4) : (f32x4){0.f, 0.f, 0.f, 0.f}; }
#pragma unroll
    for (int i = 0; i < 16; ++i) { const int kk = i * 4 + rq; LAS float* d = scr + kk * 65 + c4; d[0] = tv[i][0]; d[1] = tv[i][1]; d[2] = tv[i][2]; d[3] = tv[i][3]; }
    LDS_FENCE();
    const int c = lane & 7;
#pragma unroll
    for (int j = 0; j < 8; ++j) { const int n = (lane >> 3) + 8 * j, ng = n0 + n;
        if (ng < N) { const LAS float* sp = scr + (8 * c) * 65 + n;
            u32x4 o; o.x = cvt_pk_bf16(sp[0], sp[65]); o.y = cvt_pk_bf16(sp[130], sp[195]); o.z = cvt_pk_bf16(sp[260], sp[325]); o.w = cvt_pk_bf16(sp[390], sp[455]);
            const int dr = ng < split ? ng : ng + shift;
            *(u32x4*)(WT + (size_t)dr * ldk + k0 + 8 * c) = o; } }
    LDS_FENCE();
}
__device__ __forceinline__ void tr_matrix(const float* W, int K, int N, bf16_t* WT, int ldk, int split, int shift, LAS float* scr, int gw, int ngw, int lane) {
    const int nitems = (K >> 6) * ((N + 63) >> 6);
    for (int it = gw; it < nitems; it += ngw) tr_item(W, K, N, WT, ldk, split, shift, scr, it, lane);
}
__device__ __forceinline__ void phase_weights(KP P, LAS unsigned char* lds) {
    const int tid = fresh_tid(), wave = tid >> 6, lane = tid & 63;
    const int gw = blockIdx.x * 8 + wave, ngw = gridDim.x * 8;
    LAS float* scr = (LAS float*)(lds + wave * 16896);
    for (int l = 0; l < DEPTH; ++l) {
        tr_matrix(P->in[3] + (size_t)l * DM * NIN, DM, NIN, (bf16_t*)(P->ws + W_WIN + l * SZ_WIN), DM, NG0, GATE0 - NG0, scr, gw, ngw, lane);
        tr_matrix(P->in[26] + (size_t)l * DM * DM, DM, DM, (bf16_t*)(P->ws + W_WUP + l * SZ_WSQ), DM, 1 << 30, 0, scr, gw, ngw, lane);
        tr_matrix(P->in[28] + (size_t)l * DM * DM, DM, DM, (bf16_t*)(P->ws + W_WOUT + l * SZ_WSQ), DM, 1 << 30, 0, scr, gw, ngw, lane);
        tr_matrix(P->in[8] + (size_t)l * 448 * 768, 448, 768, (bf16_t*)(P->ws + W_WUQ + l * SZ_WUQ), 512, 1 << 30, 0, scr, gw, ngw, lane);
        tr_matrix(P->in[9] + (size_t)l * 128 * 1024, 128, 1024, (bf16_t*)(P->ws + W_WUKV + l * SZ_WUKV), 256, 1 << 30, 0, scr, gw, ngw, lane);
        tr_matrix(P->in[24] + (size_t)l * 512 * 512, 512, 512, (bf16_t*)(P->ws + W_WGLU + l * SZ_WGLU), 512, 1 << 30, 0, scr, gw, ngw, lane);
    }
    const int gt = blockIdx.x * 512 + tid, ngt = gridDim.x * 512;
    const u32x4 z = {0u, 0u, 0u, 0u};
    for (int l = 0; l < DEPTH; ++l) {
        bf16_t* w = (bf16_t*)(P->ws + W_WIN + l * SZ_WIN) + (size_t)NG0 * DM;
        for (int i = gt; i < (GATE0 - NG0) * DM / 8; i += ngt) *(u32x4*)(w + (size_t)i * 8) = z;
        bf16_t* q = (bf16_t*)(P->ws + W_WUQ + l * SZ_WUQ);
        for (int i = gt; i < 768 * 8; i += ngt) *(u32x4*)(q + (size_t)(i >> 3) * 512 + 448 + (i & 7) * 8) = z;
        bf16_t* kv = (bf16_t*)(P->ws + W_WUKV + l * SZ_WUKV);
        for (int i = gt; i < 1024 * 16; i += ngt) *(u32x4*)(kv + (size_t)(i >> 4) * 256 + 128 + (i & 15) * 8) = z;
    }
}

__device__ __forceinline__ void phase_norm(const float* x, const float* g, bf16_t* h) {
    const int tid = fresh_tid(), wave = tid >> 6, lane = tid & 63;
    for (int row = blockIdx.x * 8 + wave; row < SEQ; row += gridDim.x * 8) {
        const f32x4* xr = (const f32x4*)(x + (size_t)row * DM) + lane;
        f32x4 v[8]; float ss = 0.f;
#pragma unroll
        for (int j = 0; j < 8; ++j) { v[j] = xr[64 * j]; ss += v[j][0] * v[j][0] + v[j][1] * v[j][1] + v[j][2] * v[j][2] + v[j][3] * v[j][3]; }
        const float rstd = rsqrtf(wave_sum(ss) * (1.f / DM) + EPS);
        u32x2* o = (u32x2*)(h + (size_t)row * DM) + lane;
#pragma unroll
        for (int j = 0; j < 8; ++j) { const f32x4 gg = *((const f32x4*)g + lane + 64 * j);
            u32x2 w; w.x = cvt_pk_bf16(v[j][0] * rstd * gg[0], v[j][1] * rstd * gg[1]); w.y = cvt_pk_bf16(v[j][2] * rstd * gg[2], v[j][3] * rstd * gg[3]); o[64 * j] = w; }
    }
}

__device__ __forceinline__ void a_prep_item(KP P, int l, int item, int lane, LAS unsigned char* ldsw) {
    const bf16_t* proj = (const bf16_t*)(P->ws + W_PROJ);
    const int hh = item >> 7, tile = item & 127, g = hh >> 2, dsh = 2 * g, L = SEQ >> dsh;
    const int tq = lane >> 4, ch = lane & 15;
    float gq[8], gk[8];
#pragma unroll
    for (int e = 0; e < 8; ++e) { gq[e] = P->in[4][l * 128 + ch * 8 + e] * (0.08838834764831845f * 1.4426950408889634f); gk[e] = P->in[5][l * 128 + ch * 8 + e]; }
    bf16_t* qd = (bf16_t*)(P->ws + W_QA) + ((size_t)hh * SEQ + tile * 64) * 128 + ch * 8;
    bf16_t* kd = (bf16_t*)(P->ws + W_KA) + ((size_t)hh * SEQ + tile * 64) * 128 + ch * 8;
#pragma unroll 4
    for (int i = 0; i < 16; ++i) {
        const int tok = i * 4 + tq, sp = tile * 64 + tok, r = sp / L, m = sp - r * L, sidx = (m << dsh) + r;
        const bf16_t* src = proj + (size_t)sidx * NP + hh * 128 + ch * 8;
        float a[8], b[8]; ld8(src + O_AQ, a); ld8(src + O_AK, b);
        const u32x4 vv = *(const u32x4*)(src + O_AV);
        float ssq = 0.f, ssk = 0.f;
#pragma unroll
        for (int e = 0; e < 8; ++e) { ssq += a[e] * a[e]; ssk += b[e] * b[e]; }
        ssq += __shfl_xor(ssq, 1); ssk += __shfl_xor(ssk, 1); ssq += __shfl_xor(ssq, 2); ssk += __shfl_xor(ssk, 2);
        ssq += __shfl_xor(ssq, 4); ssk += __shfl_xor(ssk, 4); ssq += __shfl_xor(ssq, 8); ssk += __shfl_xor(ssk, 8);
        const float rq = rsqrtf(ssq * (1.f / 128) + EPS), rk = rsqrtf(ssk * (1.f / 128) + EPS);
#pragma unroll
        for (int e = 0; e < 8; ++e) { a[e] *= rq * gq[e]; b[e] *= rk * gk[e]; }
        st8(qd + (size_t)tok * 128, a); st8(kd + (size_t)tok * 128, b);
        *(LAS u32x4*)(ldsw + tok * 256 + ((ch ^ (tok >> 3)) << 4)) = vv;
    }
    LDS_FENCE();
    bf16_t* vd = (bf16_t*)(P->ws + W_VAT) + (size_t)hh * 128 * SEQ + tile * 64;
    const int c8 = lane & 7;
#pragma unroll 2
    for (int j = 0; j < 16; ++j) { const int dv = j * 8 + (lane >> 3);
        const LAS bf16_t* tp = (const LAS bf16_t*)ldsw + (c8 * 8) * 128 + (dv ^ (c8 << 3));
        u32x4 o; o.x = (unsigned)tp[0] | ((unsigned)tp[128] << 16); o.y = (unsigned)tp[256] | ((unsigned)tp[384] << 16);
        o.z = (unsigned)tp[512] | ((unsigned)tp[640] << 16); o.w = (unsigned)tp[768] | ((unsigned)tp[896] << 16);
        *(u32x4*)(vd + (size_t)dv * SEQ + c8 * 8) = o; }
    LDS_FENCE();
}
__device__ __forceinline__ void b_prep1_cq(KP P, int l, int s_, int lane) {
    const bf16_t* proj = (const bf16_t*)(P->ws + W_PROJ);
    float a[8];
#pragma unroll
    for (int e = 0; e < 8; ++e) a[e] = 0.f;
    if (lane < 56) ld8(proj + (size_t)s_ * NP + O_BCQ + lane * 8, a);
    float ss = 0.f;
#pragma unroll
    for (int e = 0; e < 8; ++e) ss += a[e] * a[e];
    const float rs = rsqrtf(wave_sum(ss) * (1.f / 448) + EPS);
    if (lane < 56) {
#pragma unroll
        for (int e = 0; e < 8; ++e) a[e] *= rs * P->in[6][l * 448 + lane * 8 + e]; }
    st8((bf16_t*)(P->ws + W_CQN) + (size_t)s_ * 512 + lane * 8, a);
}
__device__ __forceinline__ void b_prep1_ckv(KP P, int l, int item, int lane) {
    const bf16_t* proj = (const bf16_t*)(P->ws + W_PROJ);
    const int s_ = item * 4 + (lane >> 4), ch = lane & 15;
    float a[8]; ld8(proj + (size_t)s_ * NP + O_BCKV + ch * 8, a);
    float ss = 0.f;
#pragma unroll
    for (int e = 0; e < 8; ++e) ss += a[e] * a[e];
    ss += __shfl_xor(ss, 1); ss += __shfl_xor(ss, 2); ss += __shfl_xor(ss, 4); ss += __shfl_xor(ss, 8);
    const float rs = rsqrtf(ss * (1.f / 128) + EPS);
#pragma unroll
    for (int e = 0; e < 8; ++e) a[e] *= rs * P->in[7][l * 128 + ch * 8 + e];
    bf16_t* dst = (bf16_t*)(P->ws + W_CKVN) + (size_t)s_ * 256 + ch * 8;
    st8(dst, a);
    unsigned zz = 0u; asm volatile("" : "+v"(zz)); const u32x4 z = {zz, zz, zz, zz}; *(u32x4*)(dst + 128) = z;
}

__device__ __forceinline__ float log_sigmoidf_(float x) { return fminf(x, 0.f) - __logf(1.f + __expf(-fabsf(x))); }
__device__ __forceinline__ void conv8(const bf16_t* proj, const float* cw, const float* cb, int ts, int ch, float sc, float (&o)[8]) {
    float acc[8];
#pragma unroll
    for (int e = 0; e < 8; ++e) acc[e] = cb[ch + e];
#pragma unroll
    for (int j = 0; j < 4; ++j) { const int t = ts - 3 + j;
        if (t >= 0) { float a[8]; ld8(proj + (size_t)t * NP + O_CQK + ch, a);
#pragma unroll
            for (int e = 0; e < 8; ++e) acc[e] += a[e] * cw[j * 512 + ch + e]; } }
#pragma unroll
    for (int e = 0; e < 8; ++e) o[e] = siluf_(acc[e]) * sc;
}
__device__ __forceinline__ void c1_item(KP P, int l, int item, LAS unsigned char* lds) {
    const bf16_t* proj = (const bf16_t*)(P->ws + W_PROJ);
    const int tid = fresh_tid(), lane = tid & 63, wave = tid >> 6, c = item >> 2, h = item & 3, t0 = c * 64, fr = lane & 15, fq = lane >> 4;
    LAS float* wl = (LAS float*)lds;
    LAS bf16_t* VT = (LAS bf16_t*)(lds + 256);
    LAS bf16_t* KWT = VT + 128 * 72;
    const float* cw = P->in[12] + l * 2048; const float* cb = P->in[13] + l * 512;
    if (tid < 64) {
        const bf16_t* row = proj + (size_t)(t0 + lane) * NP;
        const float lf = log_sigmoidf_(bf2f(row[O_CF + h]) + P->in[15][l * 4 + h]);
        const float ig = bf2f(row[O_CI + h]) + P->in[14][l * 4 + h];
        float b = lf;
#pragma unroll
        for (int o = 1; o < 64; o <<= 1) { const float t = __shfl_up(b, o); if (lane >= o) b += t; }
        const float bL = __shfl(b, 63);
        const float gs = bL - b + ig;
        const float mloc = wave_max(gs);
        wl[lane] = __expf(gs - mloc);
        if (lane == 0) { float* meta = (float*)(P->ws + W_META) + item * 2; meta[0] = bL; meta[1] = mloc; }
    }
    __syncthreads();
    { const int s_ = tid >> 3, dg = tid & 7; float k8[8]; conv8(proj, cw, cb, t0 + s_, 256 + h * 64 + dg * 8, 0.125f, k8);
      const float w = wl[s_];
#pragma unroll
      for (int e = 0; e < 8; ++e) KWT[(dg * 8 + e) * 72 + s_] = f2bf(k8[e] * w); }
#pragma unroll
    for (int i = 0; i < 2; ++i) { const int id = tid + i * 512, s_ = id >> 4, cg8 = id & 15;
        const u32x4 vv = *(const u32x4*)(proj + (size_t)(t0 + s_) * NP + O_CV + h * 128 + cg8 * 8);
        LAS bf16_t* vp = VT + (cg8 * 8) * 72 + s_;
        vp[0] = (bf16_t)(vv.x & 0xffffu); vp[72] = (bf16_t)(vv.x >> 16); vp[144] = (bf16_t)(vv.y & 0xffffu); vp[216] = (bf16_t)(vv.y >> 16);
        vp[288] = (bf16_t)(vv.z & 0xffffu); vp[360] = (bf16_t)(vv.z >> 16); vp[432] = (bf16_t)(vv.w & 0xffffu); vp[504] = (bf16_t)(vv.w >> 16); }
    __syncthreads();
    { const int dsub = wave & 3;
#pragma unroll
      for (int vv = 0; vv < 4; ++vv) { const int vs = (wave >> 2) * 4 + vv; f32x4 acc = {0.f, 0.f, 0.f, 0.f};
#pragma unroll
          for (int ks = 0; ks < 2; ++ks) { const bf16x8 a = *(const LAS bf16x8*)(KWT + (dsub * 16 + fr) * 72 + ks * 32 + fq * 8), b = *(const LAS bf16x8*)(VT + (vs * 16 + fr) * 72 + ks * 32 + fq * 8);
              acc = __builtin_amdgcn_mfma_f32_16x16x32_bf16(a, b, acc, 0, 0, 0); }
          *(f32x4*)((float*)(P->ws + W_CLOC) + ((size_t)item * 128 + vs * 16 + fr) * 64 + dsub * 16 + fq * 4) = acc; } }
    if (tid < 64) { float nl = 0.f; for (int s_ = 0; s_ < 64; ++s_) nl += bf2f(KWT[tid * 72 + s_]); ((float*)(P->ws + W_NLOC))[item * 64 + tid] = nl; }
    __syncthreads();
}
__device__ __forceinline__ void c2_multi(KP P, int e0, int estride, const LAS float* metaL) {
    const float* locp[3]; float* stp[3]; int hh[3]; bool isn[3], ok[3]; size_t strd[3];
    float* mst = (float*)(P->ws + W_MST);
#pragma unroll
    for (int k = 0; k < 3; ++k) { const int e = e0 + k * estride; ok[k] = e < 33024; const int ec = ok[k] ? e : 0;
        isn[k] = ec >= 32768; const int ee = isn[k] ? ec - 32768 : ec;
        hh[k] = isn[k] ? ee >> 6 : ee >> 13; const int idx = isn[k] ? ee & 63 : ee & 8191; strd[k] = isn[k] ? 64 : 8192;
        locp[k] = (isn[k] ? (const float*)(P->ws + W_NLOC) : (const float*)(P->ws + W_CLOC)) + idx;
        stp[k] = (isn[k] ? (float*)(P->ws + W_NST) : (float*)(P->ws + W_CST)) + idx;
        isn[k] = isn[k] && idx == 0 && ok[k]; }
    float m[3] = {0.f, 0.f, 0.f}, val[3] = {0.f, 0.f, 0.f};
#pragma unroll 1
    for (int c0 = 0; c0 < 128; c0 += 16) {
        float lv[3][16];
#pragma unroll
        for (int k = 0; k < 3; ++k)
#pragma unroll
            for (int i = 0; i < 16; ++i) lv[k][i] = ok[k] ? locp[k][(size_t)((c0 + i) * 4 + hh[k]) * strd[k]] : 0.f;
#pragma unroll
        for (int i = 0; i < 16; ++i)
#pragma unroll
            for (int k = 0; k < 3; ++k) { const int it = (c0 + i) * 4 + hh[k]; const float bl = metaL[it * 2], ml = metaL[it * 2 + 1];
                if (ok[k]) stp[k][(size_t)it * strd[k]] = val[k];
                if (isn[k]) mst[it] = m[k];
                const float mn = fmaxf(bl + m[k], ml);
                val[k] = __expf(bl + m[k] - mn) * val[k] + __expf(ml - mn) * lv[k][i]; m[k] = mn; }
    }
}
__device__ __forceinline__ void c3_item(KP P, int l, int item, LAS unsigned char* lds) {
    const bf16_t* proj = (const bf16_t*)(P->ws + W_PROJ);
    const int tid = fresh_tid(), lane = tid & 63, wave = tid >> 6, c = item >> 2, h = item & 3, t0 = c * 64, fr = lane & 15, fq = lane >> 4;
    LAS float* bb = (LAS float*)lds;
    LAS float* gi = bb + 64;
    LAS float* mtl = gi + 64;
    LAS float* wil = mtl + 64;
    LAS float* nnl = wil + 64;
    LAS float* nql = nnl + 64;
    LAS float* rsl = nql + 64;
    LAS bf16_t* Qs = (LAS bf16_t*)(lds + 2048);
    LAS bf16_t* Ks = Qs + 64 * 72;
    LAS bf16_t* SQ = Ks + 64 * 72;
    LAS bf16_t* VT = SQ + 64 * 72;
    LAS bf16_t* Cs = VT + 128 * 72;
    const float* cw = P->in[12] + l * 2048; const float* cb = P->in[13] + l * 512;
    const float m_in = ((const float*)(P->ws + W_MST))[item];
    if (tid < 64) {
        const bf16_t* row = proj + (size_t)(t0 + lane) * NP;
        const float lf = log_sigmoidf_(bf2f(row[O_CF + h]) + P->in[15][l * 4 + h]);
        const float ig = bf2f(row[O_CI + h]) + P->in[14][l * 4 + h];
        float b = lf;
#pragma unroll
        for (int o = 1; o < 64; o <<= 1) { const float t = __shfl_up(b, o); if (lane >= o) b += t; }
        const float d = ig - b; float pm = d;
#pragma unroll
        for (int o = 1; o < 64; o <<= 1) { const float t = __shfl_up(pm, o); if (lane >= o) pm = fmaxf(pm, t); }
        const float mt = b + fmaxf(m_in, pm);
        bb[lane] = b; gi[lane] = d; mtl[lane] = mt; wil[lane] = __expf(b + m_in - mt);
        nnl[lane] = ((const float*)(P->ws + W_NST))[item * 64 + lane];
    }
    { const int s_ = tid >> 3, dg = tid & 7; float a[8]; u32x4 w;
      conv8(proj, cw, cb, t0 + s_, h * 64 + dg * 8, 1.f, a);
      w.x = cvt_pk_bf16(a[0], a[1]); w.y = cvt_pk_bf16(a[2], a[3]); w.z = cvt_pk_bf16(a[4], a[5]); w.w = cvt_pk_bf16(a[6], a[7]);
      *(LAS u32x4*)(Qs + s_ * 72 + dg * 8) = w;
      conv8(proj, cw, cb, t0 + s_, 256 + h * 64 + dg * 8, 0.125f, a);
      w.x = cvt_pk_bf16(a[0], a[1]); w.y = cvt_pk_bf16(a[2], a[3]); w.z = cvt_pk_bf16(a[4], a[5]); w.w = cvt_pk_bf16(a[6], a[7]);
      *(LAS u32x4*)(Ks + s_ * 72 + dg * 8) = w; }
#pragma unroll
    for (int i = 0; i < 2; ++i) { const int id = tid + i * 512, s_ = id >> 4, cg8 = id & 15;
        const u32x4 vv = *(const u32x4*)(proj + (size_t)(t0 + s_) * NP + O_CV + h * 128 + cg8 * 8);
        LAS bf16_t* vp = VT + (cg8 * 8) * 72 + s_;
        vp[0] = (bf16_t)(vv.x & 0xffffu); vp[72] = (bf16_t)(vv.x >> 16); vp[144] = (bf16_t)(vv.y & 0xffffu); vp[216] = (bf16_t)(vv.y >> 16);
        vp[288] = (bf16_t)(vv.z & 0xffffu); vp[360] = (bf16_t)(vv.z >> 16); vp[432] = (bf16_t)(vv.w & 0xffffu); vp[504] = (bf16_t)(vv.w >> 16); }
    { const float* cst = (const float*)(P->ws + W_CST) + (size_t)item * 8192;
#pragma unroll
      for (int i = 0; i < 4; ++i) { const int id = tid + i * 512, v = id >> 4, d4 = (id & 15) * 4; const f32x4 x = *(const f32x4*)(cst + v * 64 + d4);
          u32x2 w; w.x = cvt_pk_bf16(x[0], x[1]); w.y = cvt_pk_bf16(x[2], x[3]); *(LAS u32x2*)(Cs + v * 72 + d4) = w; } }
    __syncthreads();
    { const int tsub = wave >> 1; float rsum[4] = {0.f, 0.f, 0.f, 0.f};
#pragma unroll
      for (int q2 = 0; q2 < 2; ++q2) { const int ssub = (wave & 1) * 2 + q2; f32x4 acc = {0.f, 0.f, 0.f, 0.f};
#pragma unroll
          for (int ks = 0; ks < 2; ++ks) { const bf16x8 a = *(const LAS bf16x8*)(Qs + (tsub * 16 + fr) * 72 + ks * 32 + fq * 8), b = *(const LAS bf16x8*)(Ks + (ssub * 16 + fr) * 72 + ks * 32 + fq * 8);
              acc = __builtin_amdgcn_mfma_f32_16x16x32_bf16(a, b, acc, 0, 0, 0); }
          const int ss = ssub * 16 + fr; const float gs = gi[ss];
#pragma unroll
          for (int j = 0; j < 4; ++j) { const int tt = tsub * 16 + fq * 4 + j;
              const float val = (ss <= tt) ? __expf(bb[tt] + gs - mtl[tt]) * acc[j] : 0.f;
              SQ[tt * 72 + ss] = f2bf(val); rsum[j] += val; } }
#pragma unroll
      for (int j = 0; j < 4; ++j) { const float r = row16_sum(rsum[j]); if (fr == 0) rsl[(tsub * 16 + fq * 4 + j) * 2 + (wave & 1)] = r; } }
    { const int t = tid >> 3, part = tid & 7; float a[8]; const u32x4 u = *(const LAS u32x4*)(Qs + t * 72 + part * 8);
      a[0] = bflo(u.x); a[1] = bfhi(u.x); a[2] = bflo(u.y); a[3] = bfhi(u.y); a[4] = bflo(u.z); a[5] = bfhi(u.z); a[6] = bflo(u.w); a[7] = bfhi(u.w);
      float p = 0.f;
#pragma unroll
      for (int e = 0; e < 8; ++e) p += a[e] * nnl[part * 8 + e];
      p += __shfl_xor(p, 1); p += __shfl_xor(p, 2); p += __shfl_xor(p, 4);
      if (part == 0) nql[t] = p; }
    __syncthreads();
    { const int tsub = wave >> 1, t = tsub * 16 + fr;
      const float wi = wil[t], den = wi * nql[t] + rsl[t * 2] + rsl[t * 2 + 1];
      const float inv = 1.f / fmaxf(fabsf(den), __expf(-mtl[t]));
      bf16x8 qb[2], sb[2];
#pragma unroll
      for (int ks = 0; ks < 2; ++ks) { qb[ks] = *(const LAS bf16x8*)(Qs + t * 72 + ks * 32 + fq * 8); sb[ks] = *(const LAS bf16x8*)(SQ + t * 72 + ks * 32 + fq * 8); }
#pragma unroll
      for (int vv = 0; vv < 4; ++vv) { const int vs = (wave & 1) * 4 + vv; f32x4 inter = {0.f, 0.f, 0.f, 0.f}, intra = {0.f, 0.f, 0.f, 0.f};
#pragma unroll
          for (int ks = 0; ks < 2; ++ks) { const bf16x8 ca = *(const LAS bf16x8*)(Cs + (vs * 16 + fr) * 72 + ks * 32 + fq * 8), va = *(const LAS bf16x8*)(VT + (vs * 16 + fr) * 72 + ks * 32 + fq * 8);
              inter = __builtin_amdgcn_mfma_f32_16x16x32_bf16(ca, qb[ks], inter, 0, 0, 0);
              intra = __builtin_amdgcn_mfma_f32_16x16x32_bf16(va, sb[ks], intra, 0, 0, 0); }
          const int v0 = vs * 16 + fq * 4;
          const bf16_t* prow = proj + (size_t)(t0 + t) * NP + h * 128 + v0;
          const u32x2 op = *(const u32x2*)(prow + O_CO), zz = *(const u32x2*)(prow + O_CZ);
          const float o0 = sigmoidf_(bflo(op.x)) * (wi * inter[0] + intra[0]) * inv * siluf_(bflo(zz.x));
          const float o1 = sigmoidf_(bfhi(op.x)) * (wi * inter[1] + intra[1]) * inv * siluf_(bfhi(zz.x));
          const float o2 = sigmoidf_(bflo(op.y)) * (wi * inter[2] + intra[2]) * inv * siluf_(bflo(zz.y));
          const float o3 = sigmoidf_(bfhi(op.y)) * (wi * inter[3] + intra[3]) * inv * siluf_(bfhi(zz.y));
          u32x2 w; w.x = cvt_pk_bf16(o0, o1); w.y = cvt_pk_bf16(o2, o3);
          *(u32x2*)((bf16_t*)(P->ws + W_YS) + (size_t)(t0 + t) * DM + 1024 + h * 128 + v0) = w; } }
    __syncthreads();
}

struct S5Lane { float are, aim, bre[16], bim[16]; };
__device__ __forceinline__ void s5_setup(KP P, int l, int g, int p, S5Lane& L) {
    const int gp = (l * 32 + g) * 64 + p;
    const float lr = P->in[16][gp], li = P->in[17][gp], dt = expf(P->in[18][l * 32 + g]);
    const float mag = expf(lr * dt); float sn, cs; sincosf(li * dt, &sn, &cs);
    L.are = mag * cs; L.aim = mag * sn;
    const float den = lr * lr + li * li;
    const float fre = ((L.are - 1.f) * lr + L.aim * li) / den, fim = (L.aim * lr - (L.are - 1.f) * li) / den;
    const f32x4* br = (const f32x4*)(P->in[19] + (size_t)gp * 16); const f32x4* bi = (const f32x4*)(P->in[20] + (size_t)gp * 16);
#pragma unroll
    for (int j = 0; j < 4; ++j) { const f32x4 r = br[j], i = bi[j];
#pragma unroll
        for (int e = 0; e < 4; ++e) { L.bre[j * 4 + e] = fre * r[e] - fim * i[e]; L.bim[j * 4 + e] = fre * i[e] + fim * r[e]; } }
}
__device__ __forceinline__ void s5_step(const S5Lane& L, const bf16_t* urow, float& xr, float& xi) {
    float u0[8], u1[8]; ld8(urow, u0); ld8(urow + 8, u1);
    float br = 0.f, bi = 0.f;
#pragma unroll
    for (int e = 0; e < 8; ++e) { br += u0[e] * L.bre[e]; bi += u0[e] * L.bim[e]; }
#pragma unroll
    for (int e = 0; e < 8; ++e) { br += u1[e] * L.bre[8 + e]; bi += u1[e] * L.bim[8 + e]; }
    const float nr = L.are * xr - L.aim * xi + br, ni = L.are * xi + L.aim * xr + bi;
    xr = nr; xi = ni;
}
__device__ __forceinline__ float gelu_tanh(float x) {
    const float u = 0.7978845608028654f * (x + 0.044715f * x * x * x);
    const float e = __expf(2.f * u);
    const float th = 1.f - 2.f * __builtin_amdgcn_rcpf(e + 1.f);
    return 0.5f * x * (1.f + th);
}
__device__ __forceinline__ unsigned pack_bf2(float a, float b) { return cvt_pk_bf16(a, b); }
template <bool OUT>
__device__ __forceinline__ void s5_item(KP P, int l, int item, int lane, LAS unsigned char* ldsw) {
    const bf16_t* proj = (const bf16_t*)(P->ws + W_PROJ);
    const int c = item >> 5, g = item & 31, fr = lane & 15, fq = lane >> 4, lg = l * 32 + g;
    LAS float* buL = (LAS float*)ldsw;
    LAS bf16_t* xL = (LAS bf16_t*)(ldsw + 8448);
    const float dt = expf(P->in[18][lg]);
    float are, aim;
    { const float lr = P->in[16][lg * 64 + lane], li = P->in[17][lg * 64 + lane]; const float mag = expf(lr * dt); float sn, cs; sincosf(li * dt, &sn, &cs); are = mag * cs; aim = mag * sn; }
    bf16x8 bfr[8];
#pragma unroll
    for (int q = 0; q < 4; ++q) {
        u32x4 wr = {0u, 0u, 0u, 0u}, wi = {0u, 0u, 0u, 0u};
        if (fq < 2) {
            const int pp = q * 16 + fr, gp = lg * 64 + pp;
            const float lr = P->in[16][gp], li = P->in[17][gp]; const float mag = expf(lr * dt); float sn, cs; sincosf(li * dt, &sn, &cs);
            const float ar = mag * cs, ai = mag * sn, den = lr * lr + li * li;
            const float fre = ((ar - 1.f) * lr + ai * li) / den, fim = (ai * lr - (ar - 1.f) * li) / den;
            const f32x4 r0 = *(const f32x4*)(P->in[19] + (size_t)gp * 16 + fq * 8), r1 = *(const f32x4*)(P->in[19] + (size_t)gp * 16 + fq * 8 + 4);
            const f32x4 i0 = *(const f32x4*)(P->in[20] + (size_t)gp * 16 + fq * 8), i1 = *(const f32x4*)(P->in[20] + (size_t)gp * 16 + fq * 8 + 4);
            wr.x = pack_bf2(fre * r0[0] - fim * i0[0], fre * r0[1] - fim * i0[1]); wr.y = pack_bf2(fre * r0[2] - fim * i0[2], fre * r0[3] - fim * i0[3]);
            wr.z = pack_bf2(fre * r1[0] - fim * i1[0], fre * r1[1] - fim * i1[1]); wr.w = pack_bf2(fre * r1[2] - fim * i1[2], fre * r1[3] - fim * i1[3]);
            wi.x = pack_bf2(fre * i0[0] + fim * r0[0], fre * i0[1] + fim * r0[1]); wi.y = pack_bf2(fre * i0[2] + fim * r0[2], fre * i0[3] + fim * r0[3]);
            wi.z = pack_bf2(fre * i1[0] + fim * r1[0], fre * i1[1] + fim * r1[1]); wi.w = pack_bf2(fre * i1[2] + fim * r1[2], fre * i1[3] + fim * r1[3]);
        }
        bfr[q] = __builtin_bit_cast(bf16x8, wr); bfr[4 + q] = __builtin_bit_cast(bf16x8, wi);
    }
    bf16x8 cfr[4]; float dsk = 0.f;
    if (OUT) {
#pragma unroll
        for (int ks = 0; ks < 4; ++ks) { const float* src = (ks < 2 ? P->in[21] : P->in[22]) + ((size_t)lg * 16 + fr) * 64 + (ks & 1) * 32 + fq * 8; const float sg = ks < 2 ? 1.f : -1.f;
            const f32x4 a = *(const f32x4*)src, b = *(const f32x4*)(src + 4);
            u32x4 w; w.x = pack_bf2(sg * a[0], sg * a[1]); w.y = pack_bf2(sg * a[2], sg * a[3]); w.z = pack_bf2(sg * b[0], sg * b[1]); w.w = pack_bf2(sg * b[2], sg * b[3]);
            cfr[ks] = __builtin_bit_cast(bf16x8, w); }
        dsk = P->in[23][l * 512 + g * 16 + fr];
    }
    float xr = 0.f, xi = 0.f;
    if (OUT) { const float* xs = (const float*)(P->ws + W_XST) + ((size_t)c * 2048 + g * 64 + lane) * 2; xr = xs[0]; xi = xs[1]; }
#pragma unroll 1
    for (int sub = 0; sub < 4; ++sub) {
        const int tb = c * 64 + sub * 16;
        u32x4 uw = {0u, 0u, 0u, 0u};
        if (fq < 2) uw = *(const u32x4*)(proj + (size_t)(tb + fr) * NP + O_DU + g * 16 + fq * 8);
        const bf16x8 ua = __builtin_bit_cast(bf16x8, uw);
#pragma unroll
        for (int ns = 0; ns < 8; ++ns) { const f32x4 z = {0.f, 0.f, 0.f, 0.f}; const f32x4 r = __builtin_amdgcn_mfma_f32_16x16x32_bf16(ua, bfr[ns], z, 0, 0, 0);
#pragma unroll
            for (int j = 0; j < 4; ++j) buL[(fq * 4 + j) * 132 + ns * 16 + fr] = r[j]; }
        LDS_FENCE();
#pragma unroll
        for (int t = 0; t < 16; ++t) { const float br = buL[t * 132 + lane], bi = buL[t * 132 + 64 + lane];
            const float nr = are * xr - aim * xi + br, ni = are * xi + aim * xr + bi; xr = nr; xi = ni;
            if (OUT) { xL[t * 136 + lane] = f2bf(xr); xL[t * 136 + 64 + lane] = f2bf(xi); } }
        if (OUT) {
            LDS_FENCE();
            f32x4 y = {0.f, 0.f, 0.f, 0.f};
#pragma unroll
            for (int ks = 0; ks < 4; ++ks) { const bf16x8 af = *(const LAS bf16x8*)(xL + fr * 136 + ks * 32 + fq * 8); y = __builtin_amdgcn_mfma_f32_16x16x32_bf16(af, cfr[ks], y, 0, 0, 0); }
#pragma unroll
            for (int j = 0; j < 4; ++j) { const size_t trow = (size_t)(tb + fq * 4 + j);
                const float uu = bf2f(proj[trow * NP + O_DU + g * 16 + fr]);
                ((bf16_t*)(P->ws + W_YD))[trow * 512 + g * 16 + fr] = f2bf(gelu_tanh(y[j] + dsk * uu)); }
        }
        LDS_FENCE();
    }
    if (!OUT) { float* xe = (float*)(P->ws + W_XEND) + ((size_t)c * 2048 + g * 64 + lane) * 2; xe[0] = xr; xe[1] = xi; }
}
__device__ __forceinline__ void d2_elem(KP P, int l, int e) {
    const int gp = l * 2048 + e;
    const float lr = P->in[16][gp], li = P->in[17][gp], dt = expf(P->in[18][l * 32 + (e >> 6)]);
    const float mag = expf(lr * dt); float sn, cs; sincosf(li * dt, &sn, &cs);
    float ar = mag * cs, ai = mag * sn;
#pragma unroll
    for (int i = 0; i < 6; ++i) { const float r = ar * ar - ai * ai, im = 2.f * ar * ai; ar = r; ai = im; }
    const float* xe = (const float*)(P->ws + W_XEND); float* xs = (float*)(P->ws + W_XST);
    float xr = 0.f, xi = 0.f;
#pragma unroll 1
    for (int c0 = 0; c0 < 128; c0 += 32) {
        float er[32], ei[32];
#pragma unroll
        for (int i = 0; i < 32; ++i) { const size_t o = ((size_t)(c0 + i) * 2048 + e) * 2; er[i] = xe[o]; ei[i] = xe[o + 1]; }
#pragma unroll
        for (int i = 0; i < 32; ++i) { const size_t o = ((size_t)(c0 + i) * 2048 + e) * 2; xs[o] = xr; xs[o + 1] = xi;
            const float nr = ar * xr - ai * xi + er[i], ni = ar * xi + ai * xr + ei[i]; xr = nr; xi = ni; }
    }
}
__device__ __forceinline__ void b_prep2_item(KP P, int l, int s_, int lane) {
    const bf16_t* proj = (const bf16_t*)(P->ws + W_PROJ);
    const int h = lane >> 4, i = lane & 15;
    const bool hasr = i < 8, isx1 = i < 4;
    const float posf = (float)((const int*)P->in[1])[s_];
    float cs[8], sn[8];
#pragma unroll
    for (int e = 0; e < 8; ++e) { const int fi = (i & 3) * 8 + e;
        const float inv = exp2f(-(float)fi * 0.41524101186092029f);
        const float ang = posf * inv;
        const double t = (double)ang * 0.15915494309189535;
        const float fr = (float)(t - __builtin_rint(t));
        sn[e] = __builtin_amdgcn_sinf(fr); cs[e] = __builtin_amdgcn_cosf(fr); }
    const bf16_t* qsrc = (const bf16_t*)(P->ws + W_QRAW) + (size_t)s_ * 768 + h * 192;
    const bf16_t* ksrc = (const bf16_t*)(P->ws + W_KVRAW) + (size_t)s_ * 1024 + h * 256;
    const bf16_t* krsrc = proj + (size_t)s_ * NP + O_BKR;
    bf16_t* qd = (bf16_t*)(P->ws + W_QB) + ((size_t)h * SEQ + s_) * 192;
    bf16_t* kd = (bf16_t*)(P->ws + W_KB) + ((size_t)h * SEQ + s_) * 192;
#pragma unroll
    for (int w = 0; w < 2; ++w) {
        float a[8], ar[8];
#pragma unroll
        for (int e = 0; e < 8; ++e) ar[e] = 0.f;
        ld8((w ? ksrc : qsrc) + i * 8, a);
        if (hasr) ld8(w ? krsrc + i * 8 : qsrc + 128 + i * 8, ar);
        float ss = 0.f;
#pragma unroll
        for (int e = 0; e < 8; ++e) ss += a[e] * a[e] + ar[e] * ar[e];
        ss += __shfl_xor(ss, 1); ss += __shfl_xor(ss, 2); ss += __shfl_xor(ss, 4); ss += __shfl_xor(ss, 8);
        const float rs = rsqrtf(ss * (1.f / 192) + EPS) * (w ? 1.f : 0.07216878364870322f * 1.4426950408889634f);
        const float* gg = (w ? P->in[11] : P->in[10]) + l * 192;
        float o[8];
#pragma unroll
        for (int e = 0; e < 8; ++e) { a[e] *= rs * gg[i * 8 + e]; ar[e] *= rs * gg[128 + (i & 7) * 8 + e]; }
#pragma unroll
        for (int e = 0; e < 8; ++e) { const float pr = __shfl_xor(ar[e], 4);
            o[e] = isx1 ? ar[e] * cs[e] - pr * sn[e] : ar[e] * cs[e] + pr * sn[e]; }
        bf16_t* dd = w ? kd : qd;
        st8(dd + i * 8, a);
        if (hasr) st8(dd + 128 + i * 8, o);
    }
}

template <int DQK>
__device__ __forceinline__ void attn_block(LAS unsigned char* lds, const bf16_t* Qp, const bf16_t* Kp, const bf16_t* VTp, int q_idx0, int kt_lo, int kt_hi,
                                           int maxdelta, float bslope, int dsh, bf16_t* Op, float* Lp, int head) {
    constexpr int KS = DQK + 8, KC = DQK / 8, NKC = 64 * KC / 512, KBYTES = 64 * KS * 2, VBYTES = 128 * 72 * 2;
    const int tid = fresh_tid(), wave = tid >> 6, lane = tid & 63, fr = lane & 15, fq = lane >> 4;
    LAS unsigned char* Kb = lds; LAS unsigned char* Vb = lds + 2 * KBYTES; LAS unsigned char* Pw = lds + 2 * KBYTES + 2 * VBYTES + wave * (16 * 72 * 2);
    bf16x8 qf[DQK / 32];
#pragma unroll
    for (int ks = 0; ks < DQK / 32; ++ks) qf[ks] = *(const bf16x8*)(Qp + (size_t)(wave * 16 + fr) * DQK + ks * 32 + fq * 8);
    f32x4 o[8]; float m_run[4], l_run[4];
#pragma unroll
    for (int i = 0; i < 8; ++i) o[i] = (f32x4){0.f, 0.f, 0.f, 0.f};
#pragma unroll
    for (int j = 0; j < 4; ++j) { m_run[j] = -1e30f; l_run[j] = 0.f; }
    u32x4 kreg[NKC], vreg[2];
#define ATT_LOAD(kt) do { _Pragma("unroll") for (int _i = 0; _i < NKC; ++_i) { const int id = tid + _i * 512, row = id / KC, c8 = id - row * KC; kreg[_i] = *(const u32x4*)(Kp + (size_t)((kt) * 64 + row) * DQK + c8 * 8); } \
        _Pragma("unroll") for (int _i = 0; _i < 2; ++_i) { const int id = tid + _i * 512, row = id >> 3, c8 = id & 7; vreg[_i] = *(const u32x4*)(VTp + (size_t)row * SEQ + (kt) * 64 + c8 * 8); } } while (0)
#define ATT_STORE(buf) do { _Pragma("unroll") for (int _i = 0; _i < NKC; ++_i) { const int id = tid + _i * 512, row = id / KC, c8 = id - row * KC; *(LAS u32x4*)(Kb + (buf) * KBYTES + (row * KS + c8 * 8) * 2) = kreg[_i]; } \
        _Pragma("unroll") for (int _i = 0; _i < 2; ++_i) { const int id = tid + _i * 512, row = id >> 3, c8 = id & 7; *(LAS u32x4*)(Vb + (buf) * VBYTES + (row * 72 + c8 * 8) * 2) = vreg[_i]; } } while (0)
    if (kt_lo < kt_hi) { ATT_LOAD(kt_lo); ATT_STORE(0); }
    __syncthreads();
#pragma unroll
    for (int ks = 0; ks < DQK / 32; ++ks) asm volatile("" : "+v"(qf[ks]));
    auto tile_step = [&](auto masktag, int kt) {
        const int cur = (kt - kt_lo) & 1;
        if (kt + 1 < kt_hi) ATT_LOAD(kt + 1);
        f32x4 s[4];
#pragma unroll
        for (int n = 0; n < 4; ++n) s[n] = (f32x4){0.f, 0.f, 0.f, 0.f};
        { bf16x8 kf[2][4];
          const LAS unsigned char* kbase_p = Kb + cur * KBYTES + (fr * KS + fq * 8) * 2;
#pragma unroll
          for (int n = 0; n < 4; ++n) kf[0][n] = *(const LAS bf16x8*)(kbase_p + (n * 16 * KS) * 2);
#pragma unroll
          for (int ks = 0; ks < DQK / 32; ++ks) {
              if (ks + 1 < DQK / 32) {
#pragma unroll
                  for (int n = 0; n < 4; ++n) kf[(ks + 1) & 1][n] = *(const LAS bf16x8*)(kbase_p + (n * 16 * KS + (ks + 1) * 32) * 2); }
              __builtin_amdgcn_sched_barrier(0);
              __builtin_amdgcn_s_setprio(1);
#pragma unroll
              for (int n = 0; n < 4; ++n) s[n] = __builtin_amdgcn_mfma_f32_16x16x32_bf16(qf[ks], kf[ks & 1][n], s[n], 0, 0, 0);
              __builtin_amdgcn_s_setprio(0);
              __builtin_amdgcn_sched_barrier(0);
          } }
        if constexpr (decltype(masktag)::value) {
        const int kbase = kt * 64 + fr;
#pragma unroll
        for (int j = 0; j < 4; ++j) {
            const int qi = q_idx0 + wave * 16 + fq * 4 + j;
            float tmax = -1e30f;
#pragma unroll
            for (int n = 0; n < 4; ++n) { const int delta = qi - (kbase + n * 16); const bool valid = (unsigned)delta <= (unsigned)maxdelta;
                const float sv = valid ? s[n][j] - bslope * (float)delta : -1e30f; s[n][j] = sv; tmax = fmaxf(tmax, sv); }
            tmax = row16_max(tmax);
            const float mn = fmaxf(m_run[j], tmax), alpha = __builtin_amdgcn_exp2f(m_run[j] - mn);
            m_run[j] = mn;
            float psum = 0.f;
#pragma unroll
            for (int n = 0; n < 4; ++n) { const float p = s[n][j] > -1e29f ? __builtin_amdgcn_exp2f(s[n][j] - mn) : 0.f; psum += p;
                *(LAS bf16_t*)(Pw + ((fq * 4 + j) * 72 + n * 16 + fr) * 2) = f2bf(p); }
            l_run[j] = l_run[j] * alpha + psum;
#pragma unroll
            for (int d = 0; d < 8; ++d) o[d][j] *= alpha;
        }
        } else {
            float mn[4];
#pragma unroll
            for (int j = 0; j < 4; ++j) { float tmax = fmaxf(fmaxf(s[0][j], s[1][j]), fmaxf(s[2][j], s[3][j])); tmax = row16_max(tmax); mn[j] = fmaxf(m_run[j], tmax); }
#pragma unroll
            for (int j = 0; j < 4; ++j) { const float alpha = __builtin_amdgcn_exp2f(m_run[j] - mn[j]); m_run[j] = mn[j];
                float psum = 0.f;
#pragma unroll
                for (int n = 0; n < 4; ++n) { const float p = __builtin_amdgcn_exp2f(s[n][j] - mn[j]); psum += p;
                    *(LAS bf16_t*)(Pw + ((fq * 4 + j) * 72 + n * 16 + fr) * 2) = f2bf(p); }
                l_run[j] = l_run[j] * alpha + psum;
#pragma unroll
                for (int d = 0; d < 8; ++d) o[d][j] *= alpha; }
        }
        LDS_FENCE();
        { bf16x8 pf[2], vf[2][4];
          const LAS unsigned char* vbase_p = Vb + cur * VBYTES + (fr * 72 + fq * 8) * 2;
          pf[0] = *(const LAS bf16x8*)(Pw + (fr * 72 + fq * 8) * 2); pf[1] = *(const LAS bf16x8*)(Pw + (fr * 72 + 32 + fq * 8) * 2);
#pragma unroll
          for (int d4 = 0; d4 < 4; ++d4) vf[0][d4] = *(const LAS bf16x8*)(vbase_p + (d4 * 16 * 72) * 2);
#pragma unroll
          for (int gI = 0; gI < 4; ++gI) {
              if (gI + 1 < 4) {
#pragma unroll
                  for (int d4 = 0; d4 < 4; ++d4) vf[(gI + 1) & 1][d4] = *(const LAS bf16x8*)(vbase_p + ((((gI + 1) & 1) * 4 + d4) * 16 * 72 + ((gI + 1) >> 1) * 32) * 2); }
              __builtin_amdgcn_sched_barrier(0);
              __builtin_amdgcn_s_setprio(1);
#pragma unroll
              for (int d4 = 0; d4 < 4; ++d4) o[(gI & 1) * 4 + d4] = __builtin_amdgcn_mfma_f32_16x16x32_bf16(pf[gI >> 1], vf[gI & 1][d4], o[(gI & 1) * 4 + d4], 0, 0, 0);
              __builtin_amdgcn_s_setprio(0);
              __builtin_amdgcn_sched_barrier(0);
          } }
        if (kt + 1 < kt_hi) ATT_STORE(cur ^ 1);
        __syncthreads();
    };
    { const int kt_int = (maxdelta < (1 << 29)) ? kt_lo : min(kt_hi, max(kt_lo, q_idx0 >> 6));
      for (int kt = kt_lo; kt < kt_int; ++kt) tile_step(std::integral_constant<bool, false>{}, kt);
      for (int kt = kt_int; kt < kt_hi; ++kt) tile_step(std::integral_constant<bool, true>{}, kt); }
#undef ATT_LOAD
#undef ATT_STORE
    const int L = SEQ >> dsh;
#pragma unroll
    for (int j = 0; j < 4; ++j) {
        float lt = l_run[j]; lt += __shfl_xor(lt, 1); lt += __shfl_xor(lt, 2); lt += __shfl_xor(lt, 4); lt += __shfl_xor(lt, 8);
        const float inv = lt > 0.f ? 1.f / lt : 0.f, lse = lt > 0.f ? (m_run[j] + __log2f(lt)) * 0.6931471805599453f : -1e30f;
        const int p = q_idx0 + wave * 16 + fq * 4 + j, r = p / L, m = p - r * L, srow = (m << dsh) + r;
        bf16_t* orow = Op + (size_t)srow * 512 + head * 128 + fr;
#pragma unroll
        for (int d = 0; d < 8; ++d) orow[d * 16] = f2bf(o[d][j] * inv);
        if (fr == 0) Lp[srow * 4 + head] = lse;
    }
}

__device__ __forceinline__ f32x4 ld4bf(const bf16_t* p) { const u32x2 u = *(const u32x2*)p; return (f32x4){bflo(u.x), bfhi(u.x), bflo(u.y), bfhi(u.y)}; }
__device__ __forceinline__ void phase_combine(KP P) {
    const bf16_t* proj = (const bf16_t*)(P->ws + W_PROJ);
    bf16_t* ys = (bf16_t*)(P->ws + W_YS);
    const bf16_t* oA = (const bf16_t*)(P->ws + W_OA); const float* lA = (const float*)(P->ws + W_LSEA);
    const bf16_t* oB = (const bf16_t*)(P->ws + W_OB); const float* lB = (const float*)(P->ws + W_LSEB);
    const int tid = fresh_tid(), skip = gridDim.x > 128 ? 64 : 0;
    if ((int)blockIdx.x < skip) return;
    for (int idx = ((int)blockIdx.x - skip) * 512 + tid; idx < SEQ * 256; idx += ((int)gridDim.x - skip) * 512) {
        const int s = idx >> 8, cg4 = idx & 255, br = cg4 >> 7, c4 = (cg4 & 127) * 4, j = c4 >> 7;
        f32x4 o; u32x2 zz;
        if (br == 0) {
            const float l0 = lA[s * 4 + j], l1 = lA[(SEQ + s) * 4 + j], l2 = lA[(2 * SEQ + s) * 4 + j];
            const float mx = fmaxf(l0, fmaxf(l1, l2)); const float w0 = __expf(l0 - mx), w1 = __expf(l1 - mx), w2 = __expf(l2 - mx); const float inv = 1.f / (w0 + w1 + w2);
            const f32x4 a = ld4bf(oA + (size_t)s * 512 + c4), b = ld4bf(oA + ((size_t)SEQ + s) * 512 + c4), c = ld4bf(oA + ((size_t)2 * SEQ + s) * 512 + c4);
            o = (a * w0 + b * w1 + c * w2) * inv;
            zz = *(const u32x2*)(proj + (size_t)s * NP + O_AZ + c4);
        } else {
            const float l0 = lB[s * 4 + j], l1 = lB[(SEQ + s) * 4 + j];
            const float mx = fmaxf(l0, l1); const float w0 = __expf(l0 - mx), w1 = __expf(l1 - mx); const float inv = 1.f / (w0 + w1);
            const f32x4 a = ld4bf(oB + (size_t)s * 512 + c4), b = ld4bf(oB + ((size_t)SEQ + s) * 512 + c4);
            o = (a * w0 + b * w1) * inv;
            zz = *(const u32x2*)(proj + (size_t)s * NP + O_BZ + c4);
        }
        u32x2 w; w.x = cvt_pk_bf16(o[0] * siluf_(bflo(zz.x)), o[1] * siluf_(bfhi(zz.x))); w.y = cvt_pk_bf16(o[2] * siluf_(bflo(zz.y)), o[3] * siluf_(bfhi(zz.y)));
        *(u32x2*)(ys + (size_t)s * DM + br * 512 + c4) = w;
    }
}

#define XB_TMO      128
#define XB_XCNT(j)  (256  + 64 * (j))
#define XB_XSUB(j)  (1280 + 64 * (j))
#define XB_XGEN(j)  (2304 + 64 * (j))
#define XB_TOP      3328
#define XB_TOPGEN   3392
#define XCD_BAR_WORDS 3456
#define XB_SPIN_CAP (1u << 20)
__device__ __forceinline__ unsigned xb_ld(unsigned* p)              { return __hip_atomic_load(p, __ATOMIC_RELAXED, __HIP_MEMORY_SCOPE_AGENT); }
__device__ __forceinline__ unsigned xb_add(unsigned* p, unsigned v) { return __hip_atomic_fetch_add(p, v, __ATOMIC_RELAXED, __HIP_MEMORY_SCOPE_AGENT); }
__device__ __forceinline__ unsigned xb_xcc_id() { return (unsigned)__builtin_amdgcn_s_getreg((3 << 11) | 20) & 0xFu; }
#define XB_SPIN(cond, bar) do { unsigned _sp = 0; while (cond) { __builtin_amdgcn_s_sleep(1); \
    if ((++_sp & 255u) == 0u) { if (xb_ld(&(bar)[XB_TMO])) break; if (_sp > XB_SPIN_CAP) { atomicAdd(&(bar)[XB_TMO], 1u); break; } } } } while (0)
struct XcdBarrier { unsigned* bar; unsigned x; volatile LAS unsigned* st; };
__device__ __forceinline__ XcdBarrier xcd_barrier_post(unsigned* bar, volatile LAS unsigned* st) {
    XcdBarrier b; b.bar = bar; b.x = xb_xcc_id(); b.st = st;
    if (threadIdx.x == 0) (void)xb_add(&bar[XB_XCNT(b.x)], 1u);
    return b;
}
__device__ __forceinline__ void xcd_barrier_complete(unsigned* bar, unsigned x, unsigned& nloc, unsigned& nx) {
    const unsigned G = gridDim.x * gridDim.y * gridDim.z;
    unsigned sum, cnt, mine, sp = 0u;
    for (;;) {
        sum = 0u; cnt = 0u; mine = 0u;
#pragma unroll
        for (unsigned j = 0; j < 16; ++j) { const unsigned c = xb_ld(&bar[XB_XCNT(j)]); sum += c; cnt += (c > 0u) ? 1u : 0u; mine = (j == x) ? c : mine; }
        if (sum == G) break;
        __builtin_amdgcn_s_sleep(1);
        if ((++sp & 255u) == 0u) { if (xb_ld(&bar[XB_TMO])) break; if (sp > XB_SPIN_CAP) { atomicAdd(&bar[XB_TMO], 1u); break; } }
    }
    nloc = mine > 0u ? mine : 1u; nx = cnt > 0u ? cnt : 1u;
}
__device__ __forceinline__ void xcd_barrier(const XcdBarrier& b) {
    asm volatile("s_waitcnt vmcnt(0)" ::: "memory");
    __syncthreads();
    if (threadIdx.x == 0) {
        unsigned* bar = b.bar;
        __builtin_amdgcn_s_waitcnt(0);
        unsigned nloc = b.st[0], nx = b.st[1];
        if (nloc == 0u) { xcd_barrier_complete(bar, b.x, nloc, nx); b.st[0] = nloc; b.st[1] = nx; }
        const unsigned old = xb_add(&bar[XB_XSUB(b.x)], 1u);
        const unsigned gen = old / nloc;
        if (old + 1u == (gen + 1u) * nloc) {
            __builtin_amdgcn_fence(__ATOMIC_RELEASE, "agent");
            asm volatile("s_waitcnt vmcnt(0)" ::: "memory");
            const unsigned og = xb_add(&bar[XB_TOP], 1u);
            const unsigned tg = og / nx;
            if (og + 1u == (tg + 1u) * nx) xb_add(&bar[XB_TOPGEN], 1u);
            else XB_SPIN(xb_ld(&bar[XB_TOPGEN]) == tg, bar);
            __builtin_amdgcn_fence(__ATOMIC_ACQUIRE, "agent");
            xb_add(&bar[XB_XGEN(b.x)], 1u);
            asm volatile("s_waitcnt vmcnt(0)" ::: "memory");
        } else {
            XB_SPIN(xb_ld(&bar[XB_XGEN(b.x)]) == gen, bar);
            __builtin_amdgcn_fence(__ATOMIC_ACQUIRE, "agent");
            asm volatile("s_waitcnt vmcnt(0)" ::: "memory");
        }
    }
    __syncthreads();
}

__global__ void __launch_bounds__(512, 2) fwd_mega(Params Pk) {
    extern __shared__ __attribute__((aligned(16))) unsigned char shm[];
    LAS unsigned char* lds = (LAS unsigned char*)shm;
    cg::grid_group grid = cg::this_grid();
    const int G = gridDim.x, bid = blockIdx.x, ngw = G * 8;
    volatile LAS unsigned* xst = (volatile LAS unsigned*)(lds + LDS_BYTES - 16);
    if (threadIdx.x == 0) { xst[0] = 0u; xst[1] = 0u; }
    __syncthreads();
    const XcdBarrier xb = xcd_barrier_post((unsigned*)(fresh_params()->ws + W_BAR), xst);
#define GSYNC() xcd_barrier(xb)
    for (int rp = 0; rp < REP_W; ++rp) { KP P = fresh_params(); phase_weights(P, lds); }
    for (int l = 0; l < DEPTH; ++l) {
        for (int rp = 0; rp < REP_P1; ++rp) { KP P = fresh_params(); const float* xin = l == 0 ? P->in[0] : P->out; phase_norm(xin, P->in[2] + l * DM, (bf16_t*)(P->ws + W_H)); }
        if (l == 0) grid.sync(); else GSYNC();
        for (int rp = 0; rp < REP_P2; ++rp) { KP P = fresh_params(); bf16_t* proj = (bf16_t*)(P->ws + W_PROJ); pg8::Gemm g{(const bf16_t*)(P->ws + W_H), (const bf16_t*)(P->ws + W_WIN + l * SZ_WIN), SEQ, NP, DM};
          pg8::StaticOrder S; S.init(SEQ, NP, G, bid);
          EpiProj E{proj, P->in[27] + l * 4 * DM};
          pg8::gemm_phase(lds, g, S, E); GSYNC(); }
        for (int rp = 0; rp < REP_P3; ++rp) { KP P = fresh_params();
        { const int tid = fresh_tid(), lane = tid & 63, gw = bid * 8 + (tid >> 6); for (int r2 = 0; r2 < REP_A; ++r2) for (int it = gw; it < 1536; it += ngw) a_prep_item(P, l, it, lane, lds + (tid >> 6) * 16384); }
        { const int tid = fresh_tid(), lane = tid & 63, gw = bid * 8 + (tid >> 6); for (int it = gw; it < SEQ; it += ngw) b_prep1_cq(P, l, it, lane); for (int it = gw; it < SEQ / 4; it += ngw) b_prep1_ckv(P, l, it, lane); }
        { const int tid = fresh_tid(), lane = tid & 63, gw = bid * 8 + (tid >> 6); for (int r2 = 0; r2 < REP_D1; ++r2) for (int it = gw; it < 4096; it += ngw) s5_item<false>(P, l, it, lane, lds + (tid >> 6) * 12800); }
        __syncthreads();
        for (int it = bid; it < 512; it += G) c1_item(P, l, it, lds); GSYNC(); }
        for (int rp = 0; rp < REP_P4; ++rp) { KP P = fresh_params(); const int scanW = 32, gemmW = G - scanW;
          if (bid < gemmW) {
              { pg8::Gemm g{(const bf16_t*)(P->ws + W_CQN), (const bf16_t*)(P->ws + W_WUQ + l * SZ_WUQ), SEQ, 768, 512};
                pg8::StaticOrder S; S.init(SEQ, 768, gemmW, bid); EpiBf16 E{(bf16_t*)(P->ws + W_QRAW), 768}; pg8::gemm_phase(lds, g, S, E); }
              { pg8::Gemm g{(const bf16_t*)(P->ws + W_CKVN), (const bf16_t*)(P->ws + W_WUKV + l * SZ_WUKV), SEQ, 1024, 256};
                pg8::StaticOrder S; S.init(SEQ, 1024, gemmW, (bid + gemmW - 96) % gemmW); EpiKV E{(bf16_t*)(P->ws + W_KVRAW), (bf16_t*)(P->ws + W_VBT)}; pg8::gemm_phase(lds, g, S, E); }
          } else {
              const int tid = fresh_tid(), nst = scanW * 512;
              LAS float* metaL = (LAS float*)lds;
              for (int i = tid; i < 1024; i += 512) metaL[i] = ((const float*)(P->ws + W_META))[i];
              __syncthreads();
              { const int e = (bid - gemmW - (scanW - 4)) * 512 + tid; if (e >= 0 && e < 2048) d2_elem(P, l, e); }
              c2_multi(P, (bid - gemmW) * 512 + tid, nst, metaL);
          }
          __syncthreads();
          unsigned* ticket = (unsigned*)(P->ws + W_BAR + 14336) + l * 64;
          volatile LAS int* tk = (volatile LAS int*)(lds + LDS_BYTES - 32);
          for (;;) {
              if (threadIdx.x == 0) tk[0] = (int)atomicAdd(ticket, 1u);
              __syncthreads();
              const int it = tk[0];
              __syncthreads();
              if (it >= 768) break;
              const int hh = it >> 6, nq = it & 63, g = hh >> 2, dsh = 2 * g, L = SEQ >> dsh, p0 = nq * 128, n_in = (p0 & (L - 1)) >> 7;
              const int kt_hi = p0 / 64 + 2, kt_lo = n_in == 0 ? p0 / 64 : p0 / 64 - 2;
              const float slope = exp2f(-8.f * (float)(hh + 1) / 12.f) * (float)(1 << dsh) * 1.4426950408889634f;
              attn_block<128>(lds, (const bf16_t*)(P->ws + W_QA) + ((size_t)hh * SEQ + p0) * 128, (const bf16_t*)(P->ws + W_KA) + (size_t)hh * SEQ * 128,
                              (const bf16_t*)(P->ws + W_VAT) + (size_t)hh * 128 * SEQ, p0, kt_lo, kt_hi, 128, slope, dsh,
                              (bf16_t*)(P->ws + W_OA) + (size_t)g * SEQ * 512, (float*)(P->ws + W_LSEA) + (size_t)g * SEQ * 4, hh & 3);
          } GSYNC(); }
        for (int rp = 0; rp < REP_P5; ++rp) { KP P = fresh_params();
        { const int tid = fresh_tid(), lane = tid & 63, gw = bid * 8 + (tid >> 6); for (int it = gw; it < SEQ; it += ngw) b_prep2_item(P, l, it, lane); }
        { const int tid = fresh_tid(), lane = tid & 63, gw = bid * 8 + (tid >> 6); for (int r2 = 0; r2 < REP_D3; ++r2) for (int it = gw; it < 4096; it += ngw) s5_item<true>(P, l, it, lane, lds + (tid >> 6) * 12800); }
        __syncthreads();
        for (int r2 = 0; r2 < REP_C3; ++r2) for (int it = bid; it < 512; it += G) c3_item(P, l, it, lds); GSYNC(); }
        for (int rp = 0; rp < REP_P6; ++rp) {
        for (int slot = bid; slot < 256; slot += G) { KP P = fresh_params();
            const int h = slot & 3, part = (slot >> 2) & 1, i0 = slot >> 3;
#pragma unroll 1
            for (int rep = 0; rep < 2; ++rep) {
                const int i = rep ? 63 - i0 : i0, nkb = i + 1, h0 = (nkb + 1) >> 1;
                const int kt_lo = part ? 2 * h0 : 0, kt_hi = part ? 2 * nkb : 2 * h0;
                attn_block<192>(lds, (const bf16_t*)(P->ws + W_QB) + ((size_t)h * SEQ + i * 128) * 192, (const bf16_t*)(P->ws + W_KB) + (size_t)h * SEQ * 192,
                                (const bf16_t*)(P->ws + W_VBT) + (size_t)h * 128 * SEQ, i * 128, kt_lo, kt_hi, 1 << 30, 0.f, 0,
                                (bf16_t*)(P->ws + W_OB) + (size_t)part * SEQ * 512, (float*)(P->ws + W_LSEB) + (size_t)part * SEQ * 4, h);
            }
        }
        GSYNC(); }
        for (int rp = 0; rp < REP_P7; ++rp) {
        { KP P = fresh_params(); bf16_t* proj = (bf16_t*)(P->ws + W_PROJ); pg8::Gemm g{(const bf16_t*)(P->ws + W_YD), (const bf16_t*)(P->ws + W_WGLU + l * SZ_WGLU), SEQ, 512, 512};
          pg8::StaticOrder S; S.init(SEQ, 512, G, bid);
          EpiGlu E{(const bf16_t*)(P->ws + W_YD), proj, P->in[25] + l * 512, (bf16_t*)(P->ws + W_YS)};
          pg8::gemm_phase(lds, g, S, E); }
        { KP P = fresh_params(); phase_combine(P); }
        GSYNC(); }
        for (int rp = 0; rp < REP_P8; ++rp) { KP P = fresh_params(); bf16_t* proj = (bf16_t*)(P->ws + W_PROJ); pg8::Gemm g{(const bf16_t*)(P->ws + W_YS), (const bf16_t*)(P->ws + W_WUP + l * SZ_WSQ), SEQ, DM, DM};
          pg8::StaticOrder S; S.init(SEQ, DM, G, bid);
          EpiUp E{proj, (bf16_t*)(P->ws + W_MERGED)};
          pg8::gemm_phase(lds, g, S, E); GSYNC(); }
        for (int rp = 0; rp < REP_SYNC; ++rp) GSYNC();
        for (int rp = 0; rp < (l == 0 ? REP_P9 : 1); ++rp) { KP P = fresh_params(); const float* xin = l == 0 ? P->in[0] : P->out; pg8::Gemm g{(const bf16_t*)(P->ws + W_MERGED), (const bf16_t*)(P->ws + W_WOUT + l * SZ_WSQ), SEQ, DM, DM};
          pg8::StaticOrder S; S.init(SEQ, DM, G, bid);
          EpiOut E{xin, P->out};
          pg8::gemm_phase(lds, g, S, E); GSYNC(); }
    }
}

extern "C" void kernel_launch(void* const* d_in, const int* in_sizes, int n_in, void* d_out, int out_size, void* d_ws, size_t ws_size, hipStream_t stream) {
    static int grid_blocks = 0;
    if (!grid_blocks) {
        int dev = 0, cus = 0, per_cu = 0;
        (void)hipGetDevice(&dev);
        (void)hipDeviceGetAttribute(&cus, hipDeviceAttributeMultiprocessorCount, dev);
        (void)hipFuncSetAttribute((const void*)fwd_mega, hipFuncAttributeMaxDynamicSharedMemorySize, LDS_BYTES);
        (void)hipOccupancyMaxActiveBlocksPerMultiprocessor(&per_cu, (const void*)fwd_mega, 512, LDS_BYTES);
        (void)hipGetLastError();
        grid_blocks = cus > 0 ? cus : 256;
        if (ws_size < W_END) fprintf(stderr, "workspace too small: %zu < %zu\n", ws_size, (size_t)W_END);
        fprintf(stderr, "grid %d (cus %d per_cu %d)\n", grid_blocks, cus, per_cu);
    }
    (void)hipMemsetAsync((unsigned char*)d_ws + W_BAR, 0, 16384, stream);
    Params p{};
    for (int i = 0; i < 29; ++i) p.in[i] = (const float*)d_in[i];
    p.out = (float*)d_out; p.ws = (unsigned char*)d_ws;
    void* args[] = {&p};
    hipError_t e = hipLaunchCooperativeKernel((const void*)fwd_mega, dim3(grid_blocks), dim3(512), args, LDS_BYTES, stream);
    if (e != hipSuccess) fprintf(stderr, "cooperative launch failed: %s\n", hipGetErrorString(e));
}
```

```cpp
#include <hip/hip_runtime.h>
#include <hip/hip_cooperative_groups.h>
#include <cstdio>
#include <type_traits>
namespace cg = cooperative_groups;

#define LAS __attribute__((address_space(3)))
typedef unsigned short bf16_t;
typedef short bf16x8 __attribute__((ext_vector_type(8)));
typedef float f32x4 __attribute__((ext_vector_type(4)));
typedef unsigned u32x4 __attribute__((ext_vector_type(4)));
typedef unsigned u32x2 __attribute__((ext_vector_type(2)));

constexpr int SEQ = 8192, DM = 2048, NIN = 17544, NP = 17664, NG0 = 9352, GATE0 = 9472, DEPTH = 4;
constexpr int O_AQ = 0, O_AK = 1536, O_AV = 3072, O_AZ = 4608, O_BCQ = 5120, O_BCKV = 5568, O_BKR = 5696, O_BZ = 5760, O_CQK = 6272,
              O_CV = 6784, O_CI = 7296, O_CF = 7300, O_CO = 7304, O_CZ = 7816, O_DU = 8328, O_DZ = 8840;
constexpr float EPS = 1e-6f;
constexpr int LDS_BYTES = 144 * 1024;
#define REP_W 1
#define REP_P1 1
#define REP_SYNC 0
#define REP_P9 1
#define REP_A 1
#define REP_D1 1
#define REP_D3 1
#define REP_C3 1
#define REP_P2 1
#define REP_P3 1
#define REP_P4 1
#define REP_P5 1
#define REP_P6 1
#define REP_P7 1
#define REP_P8 1

constexpr size_t al(size_t x) { return (x + 255) & ~(size_t)255; }
constexpr size_t SZ_WIN = (size_t)NP * DM * 2, SZ_WSQ = (size_t)DM * DM * 2, SZ_WUQ = (size_t)768 * 512 * 2, SZ_WUKV = (size_t)1024 * 256 * 2, SZ_WGLU = (size_t)512 * 512 * 2;
constexpr size_t W_WIN = 0;
constexpr size_t W_WUP = W_WIN + DEPTH * SZ_WIN;
constexpr size_t W_WOUT = W_WUP + DEPTH * SZ_WSQ;
constexpr size_t W_WUQ = W_WOUT + DEPTH * SZ_WSQ;
constexpr size_t W_WUKV = W_WUQ + DEPTH * SZ_WUQ;
constexpr size_t W_WGLU = W_WUKV + DEPTH * SZ_WUKV;
constexpr size_t W_H = W_WGLU + DEPTH * SZ_WGLU;
constexpr size_t W_PROJ = W_H + (size_t)SEQ * DM * 2;
constexpr size_t W_QA = W_PROJ + (size_t)SEQ * NP * 2;
constexpr size_t W_KA = W_QA + (size_t)12 * SEQ * 128 * 2;
constexpr size_t W_VAT = W_KA + (size_t)12 * SEQ * 128 * 2;
constexpr size_t W_CQN = W_VAT + (size_t)12 * SEQ * 128 * 2;
constexpr size_t W_CKVN = W_CQN + (size_t)SEQ * 512 * 2;
constexpr size_t W_QRAW = W_CKVN + (size_t)SEQ * 256 * 2;
constexpr size_t W_KVRAW = W_QRAW + (size_t)SEQ * 768 * 2;
constexpr size_t W_QB = W_KVRAW + (size_t)SEQ * 1024 * 2;
constexpr size_t W_KB = W_QB + (size_t)4 * SEQ * 192 * 2;
constexpr size_t W_VBT = W_KB + (size_t)4 * SEQ * 192 * 2;
constexpr size_t W_OA = W_VBT + (size_t)4 * 128 * SEQ * 2;
constexpr size_t W_LSEA = W_OA + (size_t)3 * SEQ * 512 * 4;
constexpr size_t W_OB = W_LSEA + (size_t)3 * SEQ * 4 * 4;
constexpr size_t W_LSEB = W_OB + (size_t)2 * SEQ * 512 * 4;
constexpr size_t W_CLOC = W_LSEB + (size_t)2 * SEQ * 4 * 4;
constexpr size_t W_CST = W_CLOC + (size_t)512 * 8192 * 4;
constexpr size_t W_NLOC = W_CST + (size_t)512 * 8192 * 4;
constexpr size_t W_NST = W_NLOC + (size_t)512 * 64 * 4;
constexpr size_t W_META = W_NST + (size_t)512 * 64 * 4;
constexpr size_t W_MST = W_META + al(512 * 2 * 4);
constexpr size_t W_XEND = W_MST + al(512 * 4);
constexpr size_t W_XST = W_XEND + (size_t)128 * 2048 * 2 * 4;
constexpr size_t W_YD = W_XST + (size_t)128 * 2048 * 2 * 4;
constexpr size_t W_YS = W_YD + (size_t)SEQ * 512 * 2;
constexpr size_t W_MERGED = W_YS + (size_t)SEQ * DM * 2;
constexpr size_t W_BAR = W_MERGED + (size_t)SEQ * DM * 2;
constexpr size_t W_END = W_BAR + 16384;

struct Params { const float* in[29]; float* out; unsigned char* ws; };
typedef const Params __attribute__((address_space(4))) * KP;
__device__ __forceinline__ KP fresh_params() { KP p = (KP)__builtin_amdgcn_kernarg_segment_ptr(); asm volatile("" : "+s"(p)); return p; }

__device__ __forceinline__ float bflo(unsigned u) { return __uint_as_float(u << 16); }
__device__ __forceinline__ float bfhi(unsigned u) { return __uint_as_float(u & 0xffff0000u); }
__device__ __forceinline__ float bf2f(bf16_t b) { return __uint_as_float(((unsigned)b) << 16); }
__device__ __forceinline__ unsigned cvt_pk_bf16(float lo, float hi) { unsigned r; asm volatile("s_nop 0\n\tv_cvt_pk_bf16_f32 %0, %1, %2" : "=v"(r) : "v"(lo), "v"(hi)); return r; }
__device__ __forceinline__ bf16_t f2bf(float f) { return (bf16_t)(cvt_pk_bf16(f, 0.f) & 0xffffu); }
__device__ __forceinline__ void ld8(const bf16_t* p, float (&v)[8]) {
    const u32x4 u = *(const u32x4*)p;
    v[0] = bflo(u.x); v[1] = bfhi(u.x); v[2] = bflo(u.y); v[3] = bfhi(u.y); v[4] = bflo(u.z); v[5] = bfhi(u.z); v[6] = bflo(u.w); v[7] = bfhi(u.w);
}
__device__ __forceinline__ void st8(bf16_t* p, const float (&v)[8]) {
    u32x4 u; u.x = cvt_pk_bf16(v[0], v[1]); u.y = cvt_pk_bf16(v[2], v[3]); u.z = cvt_pk_bf16(v[4], v[5]); u.w = cvt_pk_bf16(v[6], v[7]);
    *(u32x4*)p = u;
}
__device__ __forceinline__ float sigmoidf_(float x) { return __builtin_amdgcn_rcpf(1.f + __expf(-x)); }
__device__ __forceinline__ float siluf_(float x) { return x * sigmoidf_(x); }
__device__ __forceinline__ float wave_sum(float v) {
#pragma unroll
    for (int o = 1; o < 64; o <<= 1) v += __shfl_xor(v, o);
    return v;
}
__device__ __forceinline__ float wave_max(float v) {
#pragma unroll
    for (int o = 1; o < 64; o <<= 1) v = fmaxf(v, __shfl_xor(v, o));
    return v;
}
__device__ __forceinline__ int fresh_tid() { int t = threadIdx.x; asm volatile("" : "+v"(t)); return t; }
template <int CTRL> __device__ __forceinline__ float dppf(float v) { return __int_as_float(__builtin_amdgcn_update_dpp(0, __float_as_int(v), CTRL, 0xf, 0xf, true)); }
__device__ __forceinline__ float row16_max(float v) { v = fmaxf(v, dppf<0x128>(v)); v = fmaxf(v, dppf<0x124>(v)); v = fmaxf(v, dppf<0x122>(v)); v = fmaxf(v, dppf<0x121>(v)); return v; }
__device__ __forceinline__ float row16_sum(float v) { v += dppf<0x128>(v); v += dppf<0x124>(v); v += dppf<0x122>(v); v += dppf<0x121>(v); return v; }
#define LDS_FENCE() asm volatile("s_waitcnt lgkmcnt(0)" ::: "memory")

namespace pg8 {
constexpr int BM = 256, BK = 64, HALF = 128, HTB = HALF * BK * 2, STAGE_BYTES = 8 * HTB, NXCD = 8, WGM = 4;
__device__ __forceinline__ int lds_byte(int r, int c) { const int st = (r >> 4) * 2 + (c >> 5), rr = r & 15, cc = c & 31, ob = rr * 64 + cc * 2; return st * 1024 + (ob ^ (((ob >> 9) & 1) << 5)); }
__device__ __forceinline__ void stage_rc(int b, int& R, int& C) { const int st = b / 1024, sb = b % 1024, swz = sb ^ (((sb >> 9) & 1) << 5); R = (st >> 1) * 16 + swz / 64; C = (st & 1) * 32 + (swz % 64) / 2; }
__device__ __forceinline__ int perm32(int rho) { const int n = rho >> 4, i = rho & 15; return 8 * (i >> 2) + 4 * n + (i & 3); }
struct Unit { int pm, pn; };
struct Gemm { const bf16_t* A; const bf16_t* Bt; int M, N, K; };
struct StaticOrder {
    int nM, nN, nwg, G, c;
    __device__ void init(int M, int N, int G_, int c_) { nM = M / BM; nN = N / BM; nwg = nM * nN; G = G_; c = c_; }
    __device__ bool next(int i, Unit& u) const {
        const long L = (long)i * G + c; if (L >= nwg) return false;
        int wgid = (int)L; { const int q = nwg / NXCD, r = nwg % NXCD, xcd = wgid % NXCD, off = wgid / NXCD; wgid = (xcd < r ? xcd * (q + 1) : r * (q + 1) + (xcd - r) * q) + off; }
        const int nig = WGM * nN, gid = wgid / nig, fm = gid * WGM, gsz = (nM - fm) < WGM ? (nM - fm) : WGM;
        u.pm = fm + ((wgid % nig) % gsz); u.pn = (wgid % nig) / gsz; return true;
    }
};

template <class Epi>
__device__ __forceinline__ void gemm_phase(LAS unsigned char* lds, const Gemm g, const StaticOrder& S, const Epi& E) {
    const int tid = fresh_tid(), wid = __builtin_amdgcn_readfirstlane(tid >> 6), lane = tid & 63, wr = wid >> 2, wc = wid & 3, fr = lane & 15, fq = lane >> 4;
    const int K = g.K, nt = K / BK;
    unsigned voffA[2], voffB[2];
#pragma unroll
    for (int i = 0; i < 2; ++i) { int R, C; stage_rc(tid * 16 + i * 8192, R, C); const int Rb = Epi::PERM ? ((R & ~31) + perm32(R & 31)) : R;
        voffA[i] = (unsigned)(R * K + C) * 2u; voffB[i] = (unsigned)(Rb * K + C) * 2u; }
    const size_t kstep = (size_t)(BK * 2);
    const size_t hstep = (size_t)HALF * K * 2;
    const size_t tstep = 2 * hstep;
    const unsigned ldsw = (unsigned)wid * 1024u;
    const int aoff = lds_byte(wr * 64 + fr, fq * 8), boff = lds_byte(wc * 32 + fr, fq * 8);
#define PG8_SA(b, h) (((b) * 2 + (h)) * HTB)
#define PG8_SB(b, h) ((4 + (b) * 2 + (h)) * HTB)
#define PG8_STAGE_(bufoff, gbase, voff) do { _Pragma("unroll") for (int _i = 0; _i < 2; ++_i) \
        __builtin_amdgcn_global_load_lds((const unsigned*)((const char*)(gbase) + (voff)[_i]), (LAS unsigned*)(lds + (bufoff) + ldsw + _i * 8192), 16, 0, 0); } while (0)
#define PG8_STAGE(bufoff, gbase) PG8_STAGE_(bufoff, gbase, voffA)
#define PG8_STAGEB(bufoff, gbase) PG8_STAGE_(bufoff, gbase, voffB)
#define PG8_LDA(dst, b, h) do { _Pragma("unroll") for (int m = 0; m < 4; ++m) _Pragma("unroll") for (int k = 0; k < 2; ++k) dst[m][k] = *(const LAS bf16x8*)(lds + PG8_SA(b, h) + aoff + m * 2048 + k * 1024); } while (0)
#define PG8_LDB(dst, b, h) do { _Pragma("unroll") for (int n = 0; n < 2; ++n) _Pragma("unroll") for (int k = 0; k < 2; ++k) dst[n][k] = *(const LAS bf16x8*)(lds + PG8_SB(b, h) + boff + n * 2048 + k * 1024); } while (0)
#define PG8_MMA(ai, bj, At, Bt) do { __builtin_amdgcn_s_setprio(1); _Pragma("unroll") for (int m = 0; m < 4; ++m) _Pragma("unroll") for (int n = 0; n < 2; ++n) _Pragma("unroll") for (int k = 0; k < 2; ++k) \
        acc[ai][bj][m][n] = __builtin_amdgcn_mfma_f32_16x16x32_bf16(Bt[n][k], At[m][k], acc[ai][bj][m][n], 0, 0, 0); __builtin_amdgcn_s_setprio(0); } while (0)
#define PG8_WAIT_V(n) asm volatile("s_waitcnt vmcnt(" #n ")" ::: "memory")
#define PG8_WAIT_L(n) asm volatile("s_waitcnt lgkmcnt(" #n ")" ::: "memory")
#define PG8_BAR __builtin_amdgcn_s_barrier()
#define PG8_SCHED __builtin_amdgcn_sched_barrier(0)
    Unit cur, nxt; int ui = 0;
    if (!S.next(0, cur)) return;
    f32x4 acc[2][2][4][2];
#pragma unroll
    for (int a = 0; a < 2; ++a)
#pragma unroll
        for (int b = 0; b < 2; ++b)
#pragma unroll
            for (int m = 0; m < 4; ++m)
#pragma unroll
                for (int n = 0; n < 2; ++n) acc[a][b][m][n] = (f32x4){0.f, 0.f, 0.f, 0.f};
    bf16x8 At[4][2], B0[2][2], B1[2][2];
    const char* cA = (const char*)g.A + (size_t)cur.pm * tstep; const char* cB = (const char*)g.Bt + (size_t)cur.pn * tstep;
    PG8_STAGEB(PG8_SB(0, 0), cB); PG8_STAGE(PG8_SA(0, 0), cA); PG8_STAGEB(PG8_SB(0, 1), cB + hstep); PG8_STAGE(PG8_SA(0, 1), cA + hstep);
    if (wr == 1) PG8_BAR;
    PG8_WAIT_V(4); PG8_BAR;
    PG8_STAGEB(PG8_SB(1, 0), cB + kstep); PG8_STAGE(PG8_SA(1, 0), cA + kstep); PG8_STAGEB(PG8_SB(1, 1), cB + hstep + kstep);
    PG8_WAIT_V(6); PG8_BAR;
    for (;;) {
        const bool has_next = S.next(ui + 1, nxt);
        const char* nA = has_next ? (const char*)g.A + (size_t)nxt.pm * tstep : cA; const char* nB = has_next ? (const char*)g.Bt + (size_t)nxt.pn * tstep : cB;
        for (int t = 0; t < nt; t += 2) {
            const bool last = (t == nt - 2);
            const char* a1 = cA + (size_t)(t + 1) * kstep;
            const char* a2 = last ? nA : cA + (size_t)(t + 2) * kstep; const char* b2 = last ? nB : cB + (size_t)(t + 2) * kstep;
            const char* a3 = a2 + kstep; const char* b3 = b2 + kstep;
            if constexpr (Epi::RESCALE) { if (t != 0 && (t & 7) == 0) { const int t2 = fresh_tid(); const int w2 = __builtin_amdgcn_readfirstlane(t2 >> 6); E.rescale(acc, cur, t >> 3, w2 >> 2, w2 & 3, t2 & 15, (t2 >> 4) & 3); } }
            PG8_LDB(B0, 0, 0); PG8_SCHED; PG8_LDA(At, 0, 0); PG8_STAGE(PG8_SA(1, 1), a1 + hstep);
            PG8_WAIT_L(8); PG8_BAR; PG8_WAIT_L(0); PG8_MMA(0, 0, At, B0); PG8_BAR; PG8_SCHED;
            PG8_LDB(B1, 0, 1); PG8_STAGEB(PG8_SB(0, 0), b2);
            PG8_BAR; PG8_WAIT_L(0); PG8_MMA(0, 1, At, B1); PG8_BAR;
            PG8_LDA(At, 0, 1); PG8_STAGE(PG8_SA(0, 0), a2);
            PG8_BAR; PG8_WAIT_L(0); PG8_MMA(1, 0, At, B0); PG8_BAR; PG8_SCHED;
            PG8_STAGEB(PG8_SB(0, 1), b2 + hstep);
            PG8_WAIT_V(6); PG8_BAR; PG8_MMA(1, 1, At, B1); PG8_BAR;
            PG8_LDB(B0, 1, 0); PG8_SCHED; PG8_LDA(At, 1, 0); PG8_STAGE(PG8_SA(0, 1), a2 + hstep);
            PG8_WAIT_L(8); PG8_BAR; PG8_WAIT_L(0); PG8_MMA(0, 0, At, B0); PG8_BAR; PG8_SCHED;
            PG8_LDB(B1, 1, 1); PG8_STAGEB(PG8_SB(1, 0), b3);
            PG8_BAR; PG8_WAIT_L(0); PG8_MMA(0, 1, At, B1); PG8_BAR;
            PG8_LDA(At, 1, 1); PG8_STAGE(PG8_SA(1, 0), a3);
            PG8_BAR; PG8_WAIT_L(0); PG8_MMA(1, 0, At, B0); PG8_BAR; PG8_SCHED;
            PG8_STAGEB(PG8_SB(1, 1), b3 + hstep);
            PG8_WAIT_V(6); PG8_BAR; PG8_MMA(1, 1, At, B1); PG8_BAR;
        }
        { const int t2 = fresh_tid(); const int w2 = __builtin_amdgcn_readfirstlane(t2 >> 6); E(acc, cur, w2 >> 2, w2 & 3, t2 & 15, (t2 >> 4) & 3); }
        if (!has_next) break;
#pragma unroll
        for (int a = 0; a < 2; ++a)
#pragma unroll
            for (int b = 0; b < 2; ++b)
#pragma unroll
                for (int m = 0; m < 4; ++m)
#pragma unroll
                    for (int n = 0; n < 2; ++n) acc[a][b][m][n] = (f32x4){0.f, 0.f, 0.f, 0.f};
        cur = nxt; cA = nA; cB = nB; ++ui;
    }
    PG8_WAIT_V(0);
    if (wr == 0) PG8_BAR;
    PG8_BAR;
#undef PG8_SA
#undef PG8_SB
#undef PG8_STAGE
#undef PG8_STAGEB
#undef PG8_STAGE_
#undef PG8_LDA
#undef PG8_LDB
#undef PG8_MMA
#undef PG8_WAIT_V
#undef PG8_WAIT_L
#undef PG8_BAR
#undef PG8_SCHED
}
}
using pg8::Unit;
typedef f32x4 AccT[2][2][4][2];

struct EpiProj {
    static constexpr bool RESCALE = false, PERM = true;
    bf16_t* O; const float* mb;
    __device__ __forceinline__ void operator()(AccT& acc, const Unit& u, int wr, int wc, int fr, int fq) const {
        int row0 = u.pm * 256 + wr * 64 + fr, col0 = u.pn * 256 + wc * 32 + 8 * fq;
        asm volatile("" : "+v"(row0), "+v"(col0));
        const bool gate = u.pn >= 37;
        f32x4 bv[2][2];
#pragma unroll
        for (int bj = 0; bj < 2; ++bj)
#pragma unroll
            for (int n = 0; n < 2; ++n) bv[bj][n] = gate ? *(const f32x4*)(mb + (col0 - GATE0) + bj * 128 + n * 4) : (f32x4){0.f, 0.f, 0.f, 0.f};
#pragma unroll
        for (int ai = 0; ai < 2; ++ai)
#pragma unroll
            for (int m = 0; m < 4; ++m) { bf16_t* rowp = O + (size_t)(row0 + ai * 128 + m * 16) * NP + col0;
#pragma unroll
                for (int bj = 0; bj < 2; ++bj) { f32x4 v0 = acc[ai][bj][m][0], v1 = acc[ai][bj][m][1];
                    if (gate) { v0 = v0 + bv[bj][0]; v1 = v1 + bv[bj][1];
                        v0[0] = sigmoidf_(v0[0]); v0[1] = sigmoidf_(v0[1]); v0[2] = sigmoidf_(v0[2]); v0[3] = sigmoidf_(v0[3]);
                        v1[0] = sigmoidf_(v1[0]); v1[1] = sigmoidf_(v1[1]); v1[2] = sigmoidf_(v1[2]); v1[3] = sigmoidf_(v1[3]); }
                    u32x4 w; w.x = cvt_pk_bf16(v0[0], v0[1]); w.y = cvt_pk_bf16(v0[2], v0[3]); w.z = cvt_pk_bf16(v1[0], v1[1]); w.w = cvt_pk_bf16(v1[2], v1[3]);
                    __builtin_nontemporal_store(w, (u32x4*)(rowp + bj * 128)); } }
    }
};
struct EpiBf16 {
    static constexpr bool RESCALE = false, PERM = true;
    bf16_t* O; int ldc;
    __device__ __forceinline__ void operator()(AccT& acc, const Unit& u, int wr, int wc, int fr, int fq) const {
        int row0 = u.pm * 256 + wr * 64 + fr, col0 = u.pn * 256 + wc * 32 + 8 * fq;
        asm volatile("" : "+v"(row0), "+v"(col0));
#pragma unroll
        for (int ai = 0; ai < 2; ++ai)
#pragma unroll
            for (int m = 0; m < 4; ++m) { bf16_t* rowp = O + (size_t)(row0 + ai * 128 + m * 16) * ldc + col0;
#pragma unroll
                for (int bj = 0; bj < 2; ++bj) { const f32x4 v0 = acc[ai][bj][m][0], v1 = acc[ai][bj][m][1];
                    u32x4 w; w.x = cvt_pk_bf16(v0[0], v0[1]); w.y = cvt_pk_bf16(v0[2], v0[3]); w.z = cvt_pk_bf16(v1[0], v1[1]); w.w = cvt_pk_bf16(v1[2], v1[3]);
                    *(u32x4*)(rowp + bj * 128) = w; } }
    }
};
struct EpiKV {
    static constexpr bool RESCALE = false, PERM = true;
    bf16_t* O; bf16_t* VT;
    __device__ __forceinline__ void operator()(AccT& acc, const Unit& u, int wr, int wc, int fr, int fq) const {
        int row0 = u.pm * 256 + wr * 64 + fr, cl = wc * 32 + 8 * fq;
        asm volatile("" : "+v"(row0), "+v"(cl));
#pragma unroll
        for (int ai = 0; ai < 2; ++ai)
#pragma unroll
            for (int m = 0; m < 4; ++m) { const int row = row0 + ai * 128 + m * 16;
                { const f32x4 v0 = acc[ai][0][m][0], v1 = acc[ai][0][m][1];
                  u32x4 w; w.x = cvt_pk_bf16(v0[0], v0[1]); w.y = cvt_pk_bf16(v0[2], v0[3]); w.z = cvt_pk_bf16(v1[0], v1[1]); w.w = cvt_pk_bf16(v1[2], v1[3]);
                  *(u32x4*)(O + (size_t)row * 1024 + u.pn * 256 + cl) = w; }
#pragma unroll
                for (int n = 0; n < 2; ++n) { const f32x4 v = acc[ai][1][m][n];
                    const unsigned w0 = cvt_pk_bf16(v[0], v[1]), w1 = cvt_pk_bf16(v[2], v[3]);
                    bf16_t* vp = VT + (size_t)(u.pn * 128 + cl + n * 4) * SEQ + row;
                    vp[0] = (bf16_t)(w0 & 0xffffu); vp[SEQ] = (bf16_t)(w0 >> 16); vp[2 * SEQ] = (bf16_t)(w1 & 0xffffu); vp[3 * SEQ] = (bf16_t)(w1 >> 16); } }
    }
};
struct EpiGlu {
    static constexpr bool RESCALE = false, PERM = true;
    const bf16_t* yd; const bf16_t* proj; const float* gb; bf16_t* ys;
    __device__ __forceinline__ void operator()(AccT& acc, const Unit& u, int wr, int wc, int fr, int fq) const {
        int row0 = u.pm * 256 + wr * 64 + fr, col0 = u.pn * 256 + wc * 32 + 8 * fq;
        asm volatile("" : "+v"(row0), "+v"(col0));
#pragma unroll
        for (int ai = 0; ai < 2; ++ai)
#pragma unroll
            for (int m = 0; m < 4; ++m) { const size_t row = (size_t)(row0 + ai * 128 + m * 16);
#pragma unroll
                for (int bj = 0; bj < 2; ++bj) { const int c = col0 + bj * 128;
                    float y8[8], z8[8], o8[8]; ld8(yd + row * 512 + c, y8); ld8(proj + row * NP + O_DZ + c, z8);
                    const f32x4 b0 = *(const f32x4*)(gb + c), b1 = *(const f32x4*)(gb + c + 4);
#pragma unroll
                    for (int e = 0; e < 4; ++e) { o8[e] = y8[e] * sigmoidf_(acc[ai][bj][m][0][e] + b0[e]) * siluf_(z8[e]); o8[4 + e] = y8[4 + e] * sigmoidf_(acc[ai][bj][m][1][e] + b1[e]) * siluf_(z8[4 + e]); }
                    st8(ys + row * DM + 1536 + c, o8); } }
    }
};
struct EpiUp {
    static constexpr bool RESCALE = true, PERM = true;
    const bf16_t* proj; bf16_t* O;
    __device__ __forceinline__ void rescale(AccT& acc, const Unit& u, int k, int wr, int wc, int fr, int fq) const {
        int row0 = u.pm * 256 + wr * 64 + fr, col0 = u.pn * 256 + wc * 32 + 8 * fq;
        asm volatile("" : "+v"(row0), "+v"(col0));
#pragma unroll
        for (int ai = 0; ai < 2; ++ai)
#pragma unroll
            for (int m = 0; m < 4; ++m) { const bf16_t* gp = proj + (size_t)(row0 + ai * 128 + m * 16) * NP + GATE0 + (k - 1) * DM + col0;
#pragma unroll
                for (int bj = 0; bj < 2; ++bj) { float ga[8], gb[8]; ld8(gp + bj * 128, ga); ld8(gp + DM + bj * 128, gb);
                    f32x4 r0, r1;
#pragma unroll
                    for (int e = 0; e < 4; ++e) { r0[e] = ga[e] * __builtin_amdgcn_rcpf(fmaxf(gb[e], 1e-30f)); r1[e] = ga[4 + e] * __builtin_amdgcn_rcpf(fmaxf(gb[4 + e], 1e-30f)); }
                    acc[ai][bj][m][0] = acc[ai][bj][m][0] * r0; acc[ai][bj][m][1] = acc[ai][bj][m][1] * r1; }
                asm volatile("" ::: "memory"); }
    }
    __device__ __forceinline__ void operator()(AccT& acc, const Unit& u, int wr, int wc, int fr, int fq) const {
        int row0 = u.pm * 256 + wr * 64 + fr, col0 = u.pn * 256 + wc * 32 + 8 * fq;
        asm volatile("" : "+v"(row0), "+v"(col0));
#pragma unroll
        for (int ai = 0; ai < 2; ++ai)
#pragma unroll
            for (int m = 0; m < 4; ++m) { const size_t row = (size_t)(row0 + ai * 128 + m * 16); const bf16_t* gp = proj + row * NP + GATE0 + 3 * DM + col0;
#pragma unroll
                for (int bj = 0; bj < 2; ++bj) { float g8[8], o8[8]; ld8(gp + bj * 128, g8);
#pragma unroll
                    for (int e = 0; e < 4; ++e) { o8[e] = acc[ai][bj][m][0][e] * g8[e]; o8[4 + e] = acc[ai][bj][m][1][e] * g8[4 + e]; }
                    st8(O + row * DM + col0 + bj * 128, o8); }
                asm volatile("" ::: "memory"); }
    }
};
struct EpiOut {
    static constexpr bool RESCALE = false, PERM = true;
    const float* xin; float* out;
    __device__ __forceinline__ void operator()(AccT& acc, const Unit& u, int wr, int wc, int fr, int fq) const {
        int row0 = u.pm * 256 + wr * 64 + fr, col0 = u.pn * 256 + wc * 32 + 8 * fq;
        asm volatile("" : "+v"(row0), "+v"(col0));
#pragma unroll
        for (int ai = 0; ai < 2; ++ai)
#pragma unroll
            for (int m = 0; m < 4; ++m) { const size_t off = (size_t)(row0 + ai * 128 + m * 16) * DM + col0;
#pragma unroll
                for (int bj = 0; bj < 2; ++bj) { const f32x4 x0 = *(const f32x4*)(xin + off + bj * 128), x1 = *(const f32x4*)(xin + off + bj * 128 + 4);
                    *(f32x4*)(out + off + bj * 128) = x0 + acc[ai][bj][m][0]; *(f32x4*)(out + off + bj * 128 + 4) = x1 + acc[ai][bj][m][1]; } }
    }
};

__device__ __forceinline__ void tr_item(const float* W, int K, int N, bf16_t* WT, int ldk, int split, int shift, LAS float* scr, int item, int lane) {
    const int nblk = (N + 63) >> 6, kb = item / nblk, nb = item - kb * nblk, k0 = 64 * kb, n0 = 64 * nb;
    const int c4 = (lane & 15) * 4, rq = lane >> 4;
    const bool okc = n0 + c4 < N;
    f32x4 tv[16];
#pragma unroll
    for (int i = 0; i < 16; ++i) { const int kk = i * 4 + rq; tv[i] = okc ? *(const f32x4*)(W + (size_t)(k0 + kk) * N + n0 + c4) : (f32x4){0.f, 0.f, 0.f, 0.f}; }
#pragma unroll
    for (int i = 0; i < 16; ++i) { const int kk = i * 4 + rq; LAS float* d = scr + kk * 65 + c4; d[0] = tv[i][0]; d[1] = tv[i][1]; d[2] = tv[i][2]; d[3] = tv[i][3]; }
    LDS_FENCE();
    const int c = lane & 7;
#pragma unroll
    for (int j = 0; j < 8; ++j) { const int n = (lane >> 3) + 8 * j, ng = n0 + n;
        if (ng < N) { const LAS float* sp = scr + (8 * c) * 65 + n;
            u32x4 o; o.x = cvt_pk_bf16(sp[0], sp[65]); o.y = cvt_pk_bf16(sp[130], sp[195]); o.z = cvt_pk_bf16(sp[260], sp[325]); o.w = cvt_pk_bf16(sp[390], sp[455]);
            const int dr = ng < split ? ng : ng + shift;
            *(u32x4*)(WT + (size_t)dr * ldk + k0 + 8 * c) = o; } }
    LDS_FENCE();
}
__device__ __forceinline__ void tr_matrix(const float* W, int K, int N, bf16_t* WT, int ldk, int split, int shift, LAS float* scr, int gw, int ngw, int lane) {
    const int nitems = (K >> 6) * ((N + 63) >> 6);
    for (int it = gw; it < nitems; it += ngw) tr_item(W, K, N, WT, ldk, split, shift, scr, it, lane);
}
__device__ __forceinline__ void phase_weights(KP P, LAS unsigned char* lds) {
    const int tid = fresh_tid(), wave = tid >> 6, lane = tid & 63;
    const int gw = blockIdx.x * 8 + wave, ngw = gridDim.x * 8;
    LAS float* scr = (LAS float*)(lds + wave * 16896);
    for (int l = 0; l < DEPTH; ++l) {
        tr_matrix(P->in[3] + (size_t)l * DM * NIN, DM, NIN, (bf16_t*)(P->ws + W_WIN + l * SZ_WIN), DM, NG0, GATE0 - NG0, scr, gw, ngw, lane);
        tr_matrix(P->in[26] + (size_t)l * DM * DM, DM, DM, (bf16_t*)(P->ws + W_WUP + l * SZ_WSQ), DM, 1 << 30, 0, scr, gw, ngw, lane);
        tr_matrix(P->in[28] + (size_t)l * DM * DM, DM, DM, (bf16_t*)(P->ws + W_WOUT + l * SZ_WSQ), DM, 1 << 30, 0, scr, gw, ngw, lane);
        tr_matrix(P->in[8] + (size_t)l * 448 * 768, 448, 768, (bf16_t*)(P->ws + W_WUQ + l * SZ_WUQ), 512, 1 << 30, 0, scr, gw, ngw, lane);
        tr_matrix(P->in[9] + (size_t)l * 128 * 1024, 128, 1024, (bf16_t*)(P->ws + W_WUKV + l * SZ_WUKV), 256, 1 << 30, 0, scr, gw, ngw, lane);
        tr_matrix(P->in[24] + (size_t)l * 512 * 512, 512, 512, (bf16_t*)(P->ws + W_WGLU + l * SZ_WGLU), 512, 1 << 30, 0, scr, gw, ngw, lane);
    }
    const int gt = blockIdx.x * 512 + tid, ngt = gridDim.x * 512;
    const u32x4 z = {0u, 0u, 0u, 0u};
    for (int l = 0; l < DEPTH; ++l) {
        bf16_t* w = (bf16_t*)(P->ws + W_WIN + l * SZ_WIN) + (size_t)NG0 * DM;
        for (int i = gt; i < (GATE0 - NG0) * DM / 8; i += ngt) *(u32x4*)(w + (size_t)i * 8) = z;
        bf16_t* q = (bf16_t*)(P->ws + W_WUQ + l * SZ_WUQ);
        for (int i = gt; i < 768 * 8; i += ngt) *(u32x4*)(q + (size_t)(i >> 3) * 512 + 448 + (i & 7) * 8) = z;
        bf16_t* kv = (bf16_t*)(P->ws + W_WUKV + l * SZ_WUKV);
        for (int i = gt; i < 1024 * 16; i += ngt) *(u32x4*)(kv + (size_t)(i >> 4) * 256 + 128 + (i & 15) * 8) = z;
    }
}

__device__ __forceinline__ void phase_norm(const float* x, const float* g, bf16_t* h) {
    const int tid = fresh_tid(), wave = tid >> 6, lane = tid & 63;
    for (int row = blockIdx.x * 8 + wave; row < SEQ; row += gridDim.x * 8) {
        const f32x4* xr = (const f32x4*)(x + (size_t)row * DM) + lane;
        f32x4 v[8]; float ss = 0.f;
#pragma unroll
        for (int j = 0; j < 8; ++j) { v[j] = xr[64 * j]; ss += v[j][0] * v[j][0] + v[j][1] * v[j][1] + v[j][2] * v[j][2] + v[j][3] * v[j][3]; }
        const float rstd = rsqrtf(wave_sum(ss) * (1.f / DM) + EPS);
        u32x2* o = (u32x2*)(h + (size_t)row * DM) + lane;
#pragma unroll
        for (int j = 0; j < 8; ++j) { const f32x4 gg = *((const f32x4*)g + lane + 64 * j);
            u32x2 w; w.x = cvt_pk_bf16(v[j][0] * rstd * gg[0], v[j][1] * rstd * gg[1]); w.y = cvt_pk_bf16(v[j][2] * rstd * gg[2], v[j][3] * rstd * gg[3]); o[64 * j] = w; }
    }
}

__device__ __forceinline__ void a_prep_item(KP P, int l, int item, int lane, LAS unsigned char* ldsw) {
    const bf16_t* proj = (const bf16_t*)(P->ws + W_PROJ);
    const int hh = item >> 7, tile = item & 127, g = hh >> 2, dsh = 2 * g, L = SEQ >> dsh;
    const int tq = lane >> 4, ch = lane & 15;
    float gq[8], gk[8];
#pragma unroll
    for (int e = 0; e < 8; ++e) { gq[e] = P->in[4][l * 128 + ch * 8 + e] * (0.08838834764831845f * 1.4426950408889634f); gk[e] = P->in[5][l * 128 + ch * 8 + e]; }
    bf16_t* qd = (bf16_t*)(P->ws + W_QA) + ((size_t)hh * SEQ + tile * 64) * 128 + ch * 8;
    bf16_t* kd = (bf16_t*)(P->ws + W_KA) + ((size_t)hh * SEQ + tile * 64) * 128 + ch * 8;
#pragma unroll 4
    for (int i = 0; i < 16; ++i) {
        const int tok = i * 4 + tq, sp = tile * 64 + tok, r = sp / L, m = sp - r * L, sidx = (m << dsh) + r;
        const bf16_t* src = proj + (size_t)sidx * NP + hh * 128 + ch * 8;
        float a[8], b[8]; ld8(src + O_AQ, a); ld8(src + O_AK, b);
        const u32x4 vv = *(const u32x4*)(src + O_AV);
        float ssq = 0.f, ssk = 0.f;
#pragma unroll
        for (int e = 0; e < 8; ++e) { ssq += a[e] * a[e]; ssk += b[e] * b[e]; }
        ssq += __shfl_xor(ssq, 1); ssk += __shfl_xor(ssk, 1); ssq += __shfl_xor(ssq, 2); ssk += __shfl_xor(ssk, 2);
        ssq += __shfl_xor(ssq, 4); ssk += __shfl_xor(ssk, 4); ssq += __shfl_xor(ssq, 8); ssk += __shfl_xor(ssk, 8);
        const float rq = rsqrtf(ssq * (1.f / 128) + EPS), rk = rsqrtf(ssk * (1.f / 128) + EPS);
#pragma unroll
        for (int e = 0; e < 8; ++e) { a[e] *= rq * gq[e]; b[e] *= rk * gk[e]; }
        st8(qd + (size_t)tok * 128, a); st8(kd + (size_t)tok * 128, b);
        *(LAS u32x4*)(ldsw + tok * 256 + ((ch ^ (tok >> 3)) << 4)) = vv;
    }
    LDS_FENCE();
    bf16_t* vd = (bf16_t*)(P->ws + W_VAT) + (size_t)hh * 128 * SEQ + tile * 64;
    const int c8 = lane & 7;
#pragma unroll 2
    for (int j = 0; j < 16; ++j) { const int dv = j * 8 + (lane >> 3);
        const LAS bf16_t* tp = (const LAS bf16_t*)ldsw + (c8 * 8) * 128 + (dv ^ (c8 << 3));
        u32x4 o; o.x = (unsigned)tp[0] | ((unsigned)tp[128] << 16); o.y = (unsigned)tp[256] | ((unsigned)tp[384] << 16);
        o.z = (unsigned)tp[512] | ((unsigned)tp[640] << 16); o.w = (unsigned)tp[768] | ((unsigned)tp[896] << 16);
        *(u32x4*)(vd + (size_t)dv * SEQ + c8 * 8) = o; }
    LDS_FENCE();
}
__device__ __forceinline__ void b_prep1_cq(KP P, int l, int s_, int lane) {
    const bf16_t* proj = (const bf16_t*)(P->ws + W_PROJ);
    float a[8];
#pragma unroll
    for (int e = 0; e < 8; ++e) a[e] = 0.f;
    if (lane < 56) ld8(proj + (size_t)s_ * NP + O_BCQ + lane * 8, a);
    float ss = 0.f;
#pragma unroll
    for (int e = 0; e < 8; ++e) ss += a[e] * a[e];
    const float rs = rsqrtf(wave_sum(ss) * (1.f / 448) + EPS);
    if (lane < 56) {
#pragma unroll
        for (int e = 0; e < 8; ++e) a[e] *= rs * P->in[6][l * 448 + lane * 8 + e]; }
    st8((bf16_t*)(P->ws + W_CQN) + (size_t)s_ * 512 + lane * 8, a);
}
__device__ __forceinline__ void b_prep1_ckv(KP P, int l, int item, int lane) {
    const bf16_t* proj = (const bf16_t*)(P->ws + W_PROJ);
    const int s_ = item * 4 + (lane >> 4), ch = lane & 15;
    float a[8]; ld8(proj + (size_t)s_ * NP + O_BCKV + ch * 8, a);
    float ss = 0.f;
#pragma unroll
    for (int e = 0; e < 8; ++e) ss += a[e] * a[e];
    ss += __shfl_xor(ss, 1); ss += __shfl_xor(ss, 2); ss += __shfl_xor(ss, 4); ss += __shfl_xor(ss, 8);
    const float rs = rsqrtf(ss * (1.f / 128) + EPS);
#pragma unroll
    for (int e = 0; e < 8; ++e) a[e] *= rs * P->in[7][l * 128 + ch * 8 + e];
    bf16_t* dst = (bf16_t*)(P->ws + W_CKVN) + (size_t)s_ * 256 + ch * 8;
    st8(dst, a);
    unsigned zz = 0u; asm volatile("" : "+v"(zz)); const u32x4 z = {zz, zz, zz, zz}; *(u32x4*)(dst + 128) = z;
}

__device__ __forceinline__ float log_sigmoidf_(float x) { return fminf(x, 0.f) - __logf(1.f + __expf(-fabsf(x))); }
__device__ __forceinline__ void conv8(const bf16_t* proj, const float* cw, const float* cb, int ts, int ch, float sc, float (&o)[8]) {
    float acc[8];
#pragma unroll
    for (int e = 0; e < 8; ++e) acc[e] = cb[ch + e];
#pragma unroll
    for (int j = 0; j < 4; ++j) { const int t = ts - 3 + j;
        if (t >= 0) { float a[8]; ld8(proj + (size_t)t * NP + O_CQK + ch, a);
#pragma unroll
            for (int e = 0; e < 8; ++e) acc[e] += a[e] * cw[j * 512 + ch + e]; } }
#pragma unroll
    for (int e = 0; e < 8; ++e) o[e] = siluf_(acc[e]) * sc;
}
__device__ __forceinline__ void c1_item(KP P, int l, int item, LAS unsigned char* lds) {
    const bf16_t* proj = (const bf16_t*)(P->ws + W_PROJ);
    const int tid = fresh_tid(), lane = tid & 63, wave = tid >> 6, c = item >> 2, h = item & 3, t0 = c * 64, fr = lane & 15, fq = lane >> 4;
    LAS float* wl = (LAS float*)lds;
    LAS bf16_t* VT = (LAS bf16_t*)(lds + 256);
    LAS bf16_t* KWT = VT + 128 * 72;
    const float* cw = P->in[12] + l * 2048; const float* cb = P->in[13] + l * 512;
    if (tid < 64) {
        const bf16_t* row = proj + (size_t)(t0 + lane) * NP;
        const float lf = log_sigmoidf_(bf2f(row[O_CF + h]) + P->in[15][l * 4 + h]);
        const float ig = bf2f(row[O_CI + h]) + P->in[14][l * 4 + h];
        float b = lf;
#pragma unroll
        for (int o = 1; o < 64; o <<= 1) { const float t = __shfl_up(b, o); if (lane >= o) b += t; }
        const float bL = __shfl(b, 63);
        const float gs = bL - b + ig;
        const float mloc = wave_max(gs);
        wl[lane] = __expf(gs - mloc);
        if (lane == 0) { float* meta = (float*)(P->ws + W_META) + item * 2; meta[0] = bL; meta[1] = mloc; }
    }
    __syncthreads();
    { const int s_ = tid >> 3, dg = tid & 7; float k8[8]; conv8(proj, cw, cb, t0 + s_, 256 + h * 64 + dg * 8, 0.125f, k8);
      const float w = wl[s_];
#pragma unroll
      for (int e = 0; e < 8; ++e) KWT[(dg * 8 + e) * 72 + s_] = f2bf(k8[e] * w); }
#pragma unroll
    for (int i = 0; i < 2; ++i) { const int id = tid + i * 512, s_ = id >> 4, cg8 = id & 15;
        const u32x4 vv = *(const u32x4*)(proj + (size_t)(t0 + s_) * NP + O_CV + h * 128 + cg8 * 8);
        LAS bf16_t* vp = VT + (cg8 * 8) * 72 + s_;
        vp[0] = (bf16_t)(vv.x & 0xffffu); vp[72] = (bf16_t)(vv.x >> 16); vp[144] = (bf16_t)(vv.y & 0xffffu); vp[216] = (bf16_t)(vv.y >> 16);
        vp[288] = (bf16_t)(vv.z & 0xffffu); vp[360] = (bf16_t)(vv.z >> 16); vp[432] = (bf16_t)(vv.w & 0xffffu); vp[504] = (bf16_t)(vv.w >> 16); }
    __syncthreads();
    { const int dsub = wave & 3;
#pragma unroll
      for (int vv = 0; vv < 4; ++vv) { const int vs = (wave >> 2) * 4 + vv; f32x4 acc = {0.f, 0.f, 0.f, 0.f};
#pragma unroll
          for (int ks = 0; ks < 2; ++ks) { const bf16x8 a = *(const LAS bf16x8*)(KWT + (dsub * 16 + fr) * 72 + ks * 32 + fq * 8), b = *(const LAS bf16x8*)(VT + (vs * 16 + fr) * 72 + ks * 32 + fq * 8);
              acc = __builtin_amdgcn_mfma_f32_16x16x32_bf16(a, b, acc, 0, 0, 0); }
          *(f32x4*)((float*)(P->ws + W_CLOC) + ((size_t)item * 128 + vs * 16 + fr) * 64 + dsub * 16 + fq * 4) = acc; } }
    if (tid < 64) { float nl = 0.f; for (int s_ = 0; s_ < 64; ++s_) nl += bf2f(KWT[tid * 72 + s_]); ((float*)(P->ws + W_NLOC))[item * 64 + tid] = nl; }
    __syncthreads();
}
__device__ __forceinline__ void c2_multi(KP P, int e0, int estride, const LAS float* metaL) {
    const float* locp[3]; float* stp[3]; int hh[3]; bool isn[3], ok[3]; size_t strd[3];
    float* mst = (float*)(P->ws + W_MST);
#pragma unroll
    for (int k = 0; k < 3; ++k) { const int e = e0 + k * estride; ok[k] = e < 33024; const int ec = ok[k] ? e : 0;
        isn[k] = ec >= 32768; const int ee = isn[k] ? ec - 32768 : ec;
        hh[k] = isn[k] ? ee >> 6 : ee >> 13; const int idx = isn[k] ? ee & 63 : ee & 8191; strd[k] = isn[k] ? 64 : 8192;
        locp[k] = (isn[k] ? (const float*)(P->ws + W_NLOC) : (const float*)(P->ws + W_CLOC)) + idx;
        stp[k] = (isn[k] ? (float*)(P->ws + W_NST) : (float*)(P->ws + W_CST)) + idx;
        isn[k] = isn[k] && idx == 0 && ok[k]; }
    float m[3] = {0.f, 0.f, 0.f}, val[3] = {0.f, 0.f, 0.f};
#pragma unroll 1
    for (int c0 = 0; c0 < 128; c0 += 16) {
        float lv[3][16];
#pragma unroll
        for (int k = 0; k < 3; ++k)
#pragma unroll
            for (int i = 0; i < 16; ++i) lv[k][i] = ok[k] ? locp[k][(size_t)((c0 + i) * 4 + hh[k]) * strd[k]] : 0.f;
#pragma unroll
        for (int i = 0; i < 16; ++i)
#pragma unroll
            for (int k = 0; k < 3; ++k) { const int it = (c0 + i) * 4 + hh[k]; const float bl = metaL[it * 2], ml = metaL[it * 2 + 1];
                if (ok[k]) stp[k][(size_t)it * strd[k]] = val[k];
                if (isn[k]) mst[it] = m[k];
                const float mn = fmaxf(bl + m[k], ml);
                val[k] = __expf(bl + m[k] - mn) * val[k] + __expf(ml - mn) * lv[k][i]; m[k] = mn; }
    }
}
__device__ __forceinline__ void c3_item(KP P, int l, int item, LAS unsigned char* lds) {
    const bf16_t* proj = (const bf16_t*)(P->ws + W_PROJ);
    const int tid = fresh_tid(), lane = tid & 63, wave = tid >> 6, c = item >> 2, h = item & 3, t0 = c * 64, fr = lane & 15, fq = lane >> 4;
    LAS float* bb = (LAS float*)lds;
    LAS float* gi = bb + 64;
    LAS float* mtl = gi + 64;
    LAS float* wil = mtl + 64;
    LAS float* nnl = wil + 64;
    LAS float* nql = nnl + 64;
    LAS float* rsl = nql + 64;
    LAS bf16_t* Qs = (LAS bf16_t*)(lds + 2048);
    LAS bf16_t* Ks = Qs + 64 * 72;
    LAS bf16_t* SQ = Ks + 64 * 72;
    LAS bf16_t* VT = SQ + 64 * 72;
    LAS bf16_t* Cs = VT + 128 * 72;
    const float* cw = P->in[12] + l * 2048; const float* cb = P->in[13] + l * 512;
    const float m_in = ((const float*)(P->ws + W_MST))[item];
    if (tid < 64) {
        const bf16_t* row = proj + (size_t)(t0 + lane) * NP;
        const float lf = log_sigmoidf_(bf2f(row[O_CF + h]) + P->in[15][l * 4 + h]);
        const float ig = bf2f(row[O_CI + h]) + P->in[14][l * 4 + h];
        float b = lf;
#pragma unroll
        for (int o = 1; o < 64; o <<= 1) { const float t = __shfl_up(b, o); if (lane >= o) b += t; }
        const float d = ig - b; float pm = d;
#pragma unroll
        for (int o = 1; o < 64; o <<= 1) { const float t = __shfl_up(pm, o); if (lane >= o) pm = fmaxf(pm, t); }
        const float mt = b + fmaxf(m_in, pm);
        bb[lane] = b; gi[lane] = d; mtl[lane] = mt; wil[lane] = __expf(b + m_in - mt);
        nnl[lane] = ((const float*)(P->ws + W_NST))[item * 64 + lane];
    }
    { const int s_ = tid >> 3, dg = tid & 7; float a[8]; u32x4 w;
      conv8(proj, cw, cb, t0 + s_, h * 64 + dg * 8, 1.f, a);
      w.x = cvt_pk_bf16(a[0], a[1]); w.y = cvt_pk_bf16(a[2], a[3]); w.z = cvt_pk_bf16(a[4], a[5]); w.w = cvt_pk_bf16(a[6], a[7]);
      *(LAS u32x4*)(Qs + s_ * 72 + dg * 8) = w;
      conv8(proj, cw, cb, t0 + s_, 256 + h * 64 + dg * 8, 0.125f, a);
      w.x = cvt_pk_bf16(a[0], a[1]); w.y = cvt_pk_bf16(a[2], a[3]); w.z = cvt_pk_bf16(a[4], a[5]); w.w = cvt_pk_bf16(a[6], a[7]);
      *(LAS u32x4*)(Ks + s_ * 72 + dg * 8) = w; }
#pragma unroll
    for (int i = 0; i < 2; ++i) { const int id = tid + i * 512, s_ = id >> 4, cg8 = id & 15;
        const u32x4 vv = *(const u32x4*)(proj + (size_t)(t0 + s_) * NP + O_CV + h * 128 + cg8 * 8);
        LAS bf16_t* vp = VT + (cg8 * 8) * 72 + s_;
        vp[0] = (bf16_t)(vv.x & 0xffffu); vp[72] = (bf16_t)(vv.x >> 16); vp[144] = (bf16_t)(vv.y & 0xffffu); vp[216] = (bf16_t)(vv.y >> 16);
        vp[288] = (bf16_t)(vv.z & 0xffffu); vp[360] = (bf16_t)(vv.z >> 16); vp[432] = (bf16_t)(vv.w & 0xffffu); vp[504] = (bf16_t)(vv.w >> 16); }
    { const float* cst = (const float*)(P->ws + W_CST) + (size_t)item * 8192;
#pragma unroll
      for (int i = 0; i < 4; ++i) { const int id = tid + i * 512, v = id >> 4, d4 = (id & 15) * 4; const f32x4 x = *(const f32x4*)(cst + v * 64 + d4);
          u32x2 w; w.x = cvt_pk_bf16(x[0], x[1]); w.y = cvt_pk_bf16(x[2], x[3]); *(LAS u32x2*)(Cs + v * 72 + d4) = w; } }
    __syncthreads();
    { const int tsub = wave >> 1; float rsum[4] = {0.f, 0.f, 0.f, 0.f};
#pragma unroll
      for (int q2 = 0; q2 < 2; ++q2) { const int ssub = (wave & 1) * 2 + q2; f32x4 acc = {0.f, 0.f, 0.f, 0.f};
#pragma unroll
          for (int ks = 0; ks < 2; ++ks) { const bf16x8 a = *(const LAS bf16x8*)(Qs + (tsub * 16 + fr) * 72 + ks * 32 + fq * 8), b = *(const LAS bf16x8*)(Ks + (ssub * 16 + fr) * 72 + ks * 32 + fq * 8);
              acc = __builtin_amdgcn_mfma_f32_16x16x32_bf16(a, b, acc, 0, 0, 0); }
          const int ss = ssub * 16 + fr; const float gs = gi[ss];
#pragma unroll
          for (int j = 0; j < 4; ++j) { const int tt = tsub * 16 + fq * 4 + j;
              const float val = (ss <= tt) ? __expf(bb[tt] + gs - mtl[tt]) * acc[j] : 0.f;
              SQ[tt * 72 + ss] = f2bf(val); rsum[j] += val; } }
#pragma unroll
      for (int j = 0; j < 4; ++j) { const float r = row16_sum(rsum[j]); if (fr == 0) rsl[(tsub * 16 + fq * 4 + j) * 2 + (wave & 1)] = r; } }
    { const int t = tid >> 3, part = tid & 7; float a[8]; const u32x4 u = *(const LAS u32x4*)(Qs + t * 72 + part * 8);
      a[0] = bflo(u.x); a[1] = bfhi(u.x); a[2] = bflo(u.y); a[3] = bfhi(u.y); a[4] = bflo(u.z); a[5] = bfhi(u.z); a[6] = bflo(u.w); a[7] = bfhi(u.w);
      float p = 0.f;
#pragma unroll
      for (int e = 0; e < 8; ++e) p += a[e] * nnl[part * 8 + e];
      p += __shfl_xor(p, 1); p += __shfl_xor(p, 2); p += __shfl_xor(p, 4);
      if (part == 0) nql[t] = p; }
    __syncthreads();
    { const int tsub = wave >> 1, t = tsub * 16 + fr;
      const float wi = wil[t], den = wi * nql[t] + rsl[t * 2] + rsl[t * 2 + 1];
      const float inv = 1.f / fmaxf(fabsf(den), __expf(-mtl[t]));
      bf16x8 qb[2], sb[2];
#pragma unroll
      for (int ks = 0; ks < 2; ++ks) { qb[ks] = *(const LAS bf16x8*)(Qs + t * 72 + ks * 32 + fq * 8); sb[ks] = *(const LAS bf16x8*)(SQ + t * 72 + ks * 32 + fq * 8); }
#pragma unroll
      for (int vv = 0; vv < 4; ++vv) { const int vs = (wave & 1) * 4 + vv; f32x4 inter = {0.f, 0.f, 0.f, 0.f}, intra = {0.f, 0.f, 0.f, 0.f};
#pragma unroll
          for (int ks = 0; ks < 2; ++ks) { const bf16x8 ca = *(const LAS bf16x8*)(Cs + (vs * 16 + fr) * 72 + ks * 32 + fq * 8), va = *(const LAS bf16x8*)(VT + (vs * 16 + fr) * 72 + ks * 32 + fq * 8);
              inter = __builtin_amdgcn_mfma_f32_16x16x32_bf16(ca, qb[ks], inter, 0, 0, 0);
              intra = __builtin_amdgcn_mfma_f32_16x16x32_bf16(va, sb[ks], intra, 0, 0, 0); }
          const int v0 = vs * 16 + fq * 4;
          const bf16_t* prow = proj + (size_t)(t0 + t) * NP + h * 128 + v0;
          const u32x2 op = *(const u32x2*)(prow + O_CO), zz = *(const u32x2*)(prow + O_CZ);
          const float o0 = sigmoidf_(bflo(op.x)) * (wi * inter[0] + intra[0]) * inv * siluf_(bflo(zz.x));
          const float o1 = sigmoidf_(bfhi(op.x)) * (wi * inter[1] + intra[1]) * inv * siluf_(bfhi(zz.x));
          const float o2 = sigmoidf_(bflo(op.y)) * (wi * inter[2] + intra[2]) * inv * siluf_(bflo(zz.y));
          const float o3 = sigmoidf_(bfhi(op.y)) * (wi * inter[3] + intra[3]) * inv * siluf_(bfhi(zz.y));
          u32x2 w; w.x = cvt_pk_bf16(o0, o1); w.y = cvt_pk_bf16(o2, o3);
          *(u32x2*)((bf16_t*)(P->ws + W_YS) + (size_t)(t0 + t) * DM + 1024 + h * 128 + v0) = w; } }
    __syncthreads();
}

struct S5Lane { float are, aim, bre[16], bim[16]; };
__device__ __forceinline__ void s5_setup(KP P, int l, int g, int p, S5Lane& L) {
    const int gp = (l * 32 + g) * 64 + p;
    const float lr = P->in[16][gp], li = P->in[17][gp], dt = expf(P->in[18][l * 32 + g]);
    const float mag = expf(lr * dt); float sn, cs; sincosf(li * dt, &sn, &cs);
    L.are = mag * cs; L.aim = mag * sn;
    const float den = lr * lr + li * li;
    const float fre = ((L.are - 1.f) * lr + L.aim * li) / den, fim = (L.aim * lr - (L.are - 1.f) * li) / den;
    const f32x4* br = (const f32x4*)(P->in[19] + (size_t)gp * 16); const f32x4* bi = (const f32x4*)(P->in[20] + (size_t)gp * 16);
#pragma unroll
    for (int j = 0; j < 4; ++j) { const f32x4 r = br[j], i = bi[j];
#pragma unroll
        for (int e = 0; e < 4; ++e) { L.bre[j * 4 + e] = fre * r[e] - fim * i[e]; L.bim[j * 4 + e] = fre * i[e] + fim * r[e]; } }
}
__device__ __forceinline__ void s5_step(const S5Lane& L, const bf16_t* urow, float& xr, float& xi) {
    float u0[8], u1[8]; ld8(urow, u0); ld8(urow + 8, u1);
    float br = 0.f, bi = 0.f;
#pragma unroll
    for (int e = 0; e < 8; ++e) { br += u0[e] * L.bre[e]; bi += u0[e] * L.bim[e]; }
#pragma unroll
    for (int e = 0; e < 8; ++e) { br += u1[e] * L.bre[8 + e]; bi += u1[e] * L.bim[8 + e]; }
    const float nr = L.are * xr - L.aim * xi + br, ni = L.are * xi + L.aim * xr + bi;
    xr = nr; xi = ni;
}
__device__ __forceinline__ float gelu_tanh(float x) {
    const float u = 0.7978845608028654f * (x + 0.044715f * x * x * x);
    const float e = __expf(2.f * u);
    const float th = 1.f - 2.f * __builtin_amdgcn_rcpf(e + 1.f);
    return 0.5f * x * (1.f + th);
}
__device__ __forceinline__ unsigned pack_bf2(float a, float b) { return cvt_pk_bf16(a, b); }
template <bool OUT>
__device__ __forceinline__ void s5_item(KP P, int l, int item, int lane, LAS unsigned char* ldsw) {
    const bf16_t* proj = (const bf16_t*)(P->ws + W_PROJ);
    const int c = item >> 5, g = item & 31, fr = lane & 15, fq = lane >> 4, lg = l * 32 + g;
    LAS float* buL = (LAS float*)ldsw;
    LAS bf16_t* xL = (LAS bf16_t*)(ldsw + 8448);
    const float dt = expf(P->in[18][lg]);
    float are, aim;
    { const float lr = P->in[16][lg * 64 + lane], li = P->in[17][lg * 64 + lane]; const float mag = expf(lr * dt); float sn, cs; sincosf(li * dt, &sn, &cs); are = mag * cs; aim = mag * sn; }
    bf16x8 bfr[8];
#pragma unroll
    for (int q = 0; q < 4; ++q) {
        u32x4 wr = {0u, 0u, 0u, 0u}, wi = {0u, 0u, 0u, 0u};
        if (fq < 2) {
            const int pp = q * 16 + fr, gp = lg * 64 + pp;
            const float lr = P->in[16][gp], li = P->in[17][gp]; const float mag = expf(lr * dt); float sn, cs; sincosf(li * dt, &sn, &cs);
            const float ar = mag * cs, ai = mag * sn, den = lr * lr + li * li;
            const float fre = ((ar - 1.f) * lr + ai * li) / den, fim = (ai * lr - (ar - 1.f) * li) / den;
            const f32x4 r0 = *(const f32x4*)(P->in[19] + (size_t)gp * 16 + fq * 8), r1 = *(const f32x4*)(P->in[19] + (size_t)gp * 16 + fq * 8 + 4);
            const f32x4 i0 = *(const f32x4*)(P->in[20] + (size_t)gp * 16 + fq * 8), i1 = *(const f32x4*)(P->in[20] + (size_t)gp * 16 + fq * 8 + 4);
            wr.x = pack_bf2(fre * r0[0] - fim * i0[0], fre * r0[1] - fim * i0[1]); wr.y = pack_bf2(fre * r0[2] - fim * i0[2], fre * r0[3] - fim * i0[3]);
            wr.z = pack_bf2(fre * r1[0] - fim * i1[0], fre * r1[1] - fim * i1[1]); wr.w = pack_bf2(fre * r1[2] - fim * i1[2], fre * r1[3] - fim * i1[3]);
            wi.x = pack_bf2(fre * i0[0] + fim * r0[0], fre * i0[1] + fim * r0[1]); wi.y = pack_bf2(fre * i0[2] + fim * r0[2], fre * i0[3] + fim * r0[3]);
            wi.z = pack_bf2(fre * i1[0] + fim * r1[0], fre * i1[1] + fim * r1[1]); wi.w = pack_bf2(fre * i1[2] + fim * r1[2], fre * i1[3] + fim * r1[3]);
        }
        bfr[q] = __builtin_bit_cast(bf16x8, wr); bfr[4 + q] = __builtin_bit_cast(bf16x8, wi);
    }
    bf16x8 cfr[4]; float dsk = 0.f;
    if (OUT) {
#pragma unroll
        for (int ks = 0; ks < 4; ++ks) { const float* src = (ks < 2 ? P->in[21] : P->in[22]) + ((size_t)lg * 16 + fr) * 64 + (ks & 1) * 32 + fq * 8; const float sg = ks < 2 ? 1.f : -1.f;
            const f32x4 a = *(const f32x4*)src, b = *(const f32x4*)(src + 4);
            u32x4 w; w.x = pack_bf2(sg * a[0], sg * a[1]); w.y = pack_bf2(sg * a[2], sg * a[3]); w.z = pack_bf2(sg * b[0], sg * b[1]); w.w = pack_bf2(sg * b[2], sg * b[3]);
            cfr[ks] = __builtin_bit_cast(bf16x8, w); }
        dsk = P->in[23][l * 512 + g * 16 + fr];
    }
    float xr = 0.f, xi = 0.f;
    if (OUT) { const float* xs = (const float*)(P->ws + W_XST) + ((size_t)c * 2048 + g * 64 + lane) * 2; xr = xs[0]; xi = xs[1]; }
#pragma unroll 1
    for (int sub = 0; sub < 4; ++sub) {
        const int tb = c * 64 + sub * 16;
        u32x4 uw = {0u, 0u, 0u, 0u};
        if (fq < 2) uw = *(const u32x4*)(proj + (size_t)(tb + fr) * NP + O_DU + g * 16 + fq * 8);
        const bf16x8 ua = __builtin_bit_cast(bf16x8, uw);
#pragma unroll
        for (int ns = 0; ns < 8; ++ns) { const f32x4 z = {0.f, 0.f, 0.f, 0.f}; const f32x4 r = __builtin_amdgcn_mfma_f32_16x16x32_bf16(ua, bfr[ns], z, 0, 0, 0);
#pragma unroll
            for (int j = 0; j < 4; ++j) buL[(fq * 4 + j) * 132 + ns * 16 + fr] = r[j]; }
        LDS_FENCE();
#pragma unroll
        for (int t = 0; t < 16; ++t) { const float br = buL[t * 132 + lane], bi = buL[t * 132 + 64 + lane];
            const float nr = are * xr - aim * xi + br, ni = are * xi + aim * xr + bi; xr = nr; xi = ni;
            if (OUT) { xL[t * 136 + lane] = f2bf(xr); xL[t * 136 + 64 + lane] = f2bf(xi); } }
        if (OUT) {
            LDS_FENCE();
            f32x4 y = {0.f, 0.f, 0.f, 0.f};
#pragma unroll
            for (int ks = 0; ks < 4; ++ks) { const bf16x8 af = *(const LAS bf16x8*)(xL + fr * 136 + ks * 32 + fq * 8); y = __builtin_amdgcn_mfma_f32_16x16x32_bf16(af, cfr[ks], y, 0, 0, 0); }
#pragma unroll
            for (int j = 0; j < 4; ++j) { const size_t trow = (size_t)(tb + fq * 4 + j);
                const float uu = bf2f(proj[trow * NP + O_DU + g * 16 + fr]);
                ((bf16_t*)(P->ws + W_YD))[trow * 512 + g * 16 + fr] = f2bf(gelu_tanh(y[j] + dsk * uu)); }
        }
        LDS_FENCE();
    }
    if (!OUT) { float* xe = (float*)(P->ws + W_XEND) + ((size_t)c * 2048 + g * 64 + lane) * 2; xe[0] = xr; xe[1] = xi; }
}
__device__ __forceinline__ void d2_elem(KP P, int l, int e) {
    const int gp = l * 2048 + e;
    const float lr = P->in[16][gp], li = P->in[17][gp], dt = expf(P->in[18][l * 32 + (e >> 6)]);
    const float mag = expf(lr * dt); float sn, cs; sincosf(li * dt, &sn, &cs);
    float ar = mag * cs, ai = mag * sn;
#pragma unroll
    for (int i = 0; i < 6; ++i) { const float r = ar * ar - ai * ai, im = 2.f * ar * ai; ar = r; ai = im; }
    const float* xe = (const float*)(P->ws + W_XEND); float* xs = (float*)(P->ws + W_XST);
    float xr = 0.f, xi = 0.f;
#pragma unroll 1
    for (int c0 = 0; c0 < 128; c0 += 32) {
        float er[32], ei[32];
#pragma unroll
        for (int i = 0; i < 32; ++i) { const size_t o = ((size_t)(c0 + i) * 2048 + e) * 2; er[i] = xe[o]; ei[i] = xe[o + 1]; }
#pragma unroll
        for (int i = 0; i < 32; ++i) { const size_t o = ((size_t)(c0 + i) * 2048 + e) * 2; xs[o] = xr; xs[o + 1] = xi;
            const float nr = ar * xr - ai * xi + er[i], ni = ar * xi + ai * xr + ei[i]; xr = nr; xi = ni; }
    }
}
__device__ __forceinline__ void b_prep2_item(KP P, int l, int s_, int lane) {
    const bf16_t* proj = (const bf16_t*)(P->ws + W_PROJ);
    const int h = lane >> 4, i = lane & 15;
    const bool hasr = i < 8, isx1 = i < 4;
    const float posf = (float)((const int*)P->in[1])[s_];
    float cs[8], sn[8];
#pragma unroll
    for (int e = 0; e < 8; ++e) { const int fi = (i & 3) * 8 + e;
        const float inv = exp2f(-(float)fi * 0.41524101186092029f);
        const float ang = posf * inv;
        const double t = (double)ang * 0.15915494309189535;
        const float fr = (float)(t - __builtin_rint(t));
        sn[e] = __builtin_amdgcn_sinf(fr); cs[e] = __builtin_amdgcn_cosf(fr); }
    const bf16_t* qsrc = (const bf16_t*)(P->ws + W_QRAW) + (size_t)s_ * 768 + h * 192;
    const bf16_t* ksrc = (const bf16_t*)(P->ws + W_KVRAW) + (size_t)s_ * 1024 + h * 256;
    const bf16_t* krsrc = proj + (size_t)s_ * NP + O_BKR;
    bf16_t* qd = (bf16_t*)(P->ws + W_QB) + ((size_t)h * SEQ + s_) * 192;
    bf16_t* kd = (bf16_t*)(P->ws + W_KB) + ((size_t)h * SEQ + s_) * 192;
#pragma unroll
    for (int w = 0; w < 2; ++w) {
        float a[8], ar[8];
#pragma unroll
        for (int e = 0; e < 8; ++e) ar[e] = 0.f;
        ld8((w ? ksrc : qsrc) + i * 8, a);
        if (hasr) ld8(w ? krsrc + i * 8 : qsrc + 128 + i * 8, ar);
        float ss = 0.f;
#pragma unroll
        for (int e = 0; e < 8; ++e) ss += a[e] * a[e] + ar[e] * ar[e];
        ss += __shfl_xor(ss, 1); ss += __shfl_xor(ss, 2); ss += __shfl_xor(ss, 4); ss += __shfl_xor(ss, 8);
        const float rs = rsqrtf(ss * (1.f / 192) + EPS) * (w ? 1.f : 0.07216878364870322f * 1.4426950408889634f);
        const float* gg = (w ? P->in[11] : P->in[10]) + l * 192;
        float o[8];
#pragma unroll
        for (int e = 0; e < 8; ++e) { a[e] *= rs * gg[i * 8 + e]; ar[e] *= rs * gg[128 + (i & 7) * 8 + e]; }
#pragma unroll
        for (int e = 0; e < 8; ++e) { const float pr = __shfl_xor(ar[e], 4);
            o[e] = isx1 ? ar[e] * cs[e] - pr * sn[e] : ar[e] * cs[e] + pr * sn[e]; }
        bf16_t* dd = w ? kd : qd;
        st8(dd + i * 8, a);
        if (hasr) st8(dd + 128 + i * 8, o);
    }
}

template <int DQK>
__device__ __forceinline__ void attn_block(LAS unsigned char* lds, const bf16_t* Qp, const bf16_t* Kp, const bf16_t* VTp, int q_idx0, int kt_lo, int kt_hi,
                                           int maxdelta, float bslope, int dsh, bf16_t* Op, float* Lp, int head) {
    constexpr int KS = DQK + 8, KC = DQK / 8, NKC = 64 * KC / 512, KBYTES = 64 * KS * 2, VBYTES = 128 * 72 * 2;
    const int tid = fresh_tid(), wave = tid >> 6, lane = tid & 63, fr = lane & 15, fq = lane >> 4;
    LAS unsigned char* Kb = lds; LAS unsigned char* Vb = lds + 2 * KBYTES; LAS unsigned char* Pw = lds + 2 * KBYTES + 2 * VBYTES + wave * (16 * 72 * 2);
    bf16x8 qf[DQK / 32];
#pragma unroll
    for (int ks = 0; ks < DQK / 32; ++ks) qf[ks] = *(const bf16x8*)(Qp + (size_t)(wave * 16 + fr) * DQK + ks * 32 + fq * 8);
    f32x4 o[8]; float m_run[4], l_run[4];
#pragma unroll
    for (int i = 0; i < 8; ++i) o[i] = (f32x4){0.f, 0.f, 0.f, 0.f};
#pragma unroll
    for (int j = 0; j < 4; ++j) { m_run[j] = -1e30f; l_run[j] = 0.f; }
    u32x4 kreg[NKC], vreg[2];
#define ATT_LOAD(kt) do { _Pragma("unroll") for (int _i = 0; _i < NKC; ++_i) { const int id = tid + _i * 512, row = id / KC, c8 = id - row * KC; kreg[_i] = *(const u32x4*)(Kp + (size_t)((kt) * 64 + row) * DQK + c8 * 8); } \
        _Pragma("unroll") for (int _i = 0; _i < 2; ++_i) { const int id = tid + _i * 512, row = id >> 3, c8 = id & 7; vreg[_i] = *(const u32x4*)(VTp + (size_t)row * SEQ + (kt) * 64 + c8 * 8); } } while (0)
#define ATT_STORE(buf) do { _Pragma("unroll") for (int _i = 0; _i < NKC; ++_i) { const int id = tid + _i * 512, row = id / KC, c8 = id - row * KC; *(LAS u32x4*)(Kb + (buf) * KBYTES + (row * KS + c8 * 8) * 2) = kreg[_i]; } \
        _Pragma("unroll") for (int _i = 0; _i < 2; ++_i) { const int id = tid + _i * 512, row = id >> 3, c8 = id & 7; *(LAS u32x4*)(Vb + (buf) * VBYTES + (row * 72 + c8 * 8) * 2) = vreg[_i]; } } while (0)
    if (kt_lo < kt_hi) { ATT_LOAD(kt_lo); ATT_STORE(0); }
    __syncthreads();
#pragma unroll
    for (int ks = 0; ks < DQK / 32; ++ks) asm volatile("" : "+v"(qf[ks]));
    auto tile_step = [&](auto masktag, int kt) {
        const int cur = (kt - kt_lo) & 1;
        if (kt + 1 < kt_hi) ATT_LOAD(kt + 1);
        f32x4 s[4];
#pragma unroll
        for (int n = 0; n < 4; ++n) s[n] = (f32x4){0.f, 0.f, 0.f, 0.f};
        { bf16x8 kf[2][4];
          const LAS unsigned char* kbase_p = Kb + cur * KBYTES + (fr * KS + fq * 8) * 2;
#pragma unroll
          for (int n = 0; n < 4; ++n) kf[0][n] = *(const LAS bf16x8*)(kbase_p + (n * 16 * KS) * 2);
#pragma unroll
          for (int ks = 0; ks < DQK / 32; ++ks) {
              if (ks + 1 < DQK / 32) {
#pragma unroll
                  for (int n = 0; n < 4; ++n) kf[(ks + 1) & 1][n] = *(const LAS bf16x8*)(kbase_p + (n * 16 * KS + (ks + 1) * 32) * 2); }
              __builtin_amdgcn_sched_barrier(0);
#pragma unroll
              for (int n = 0; n < 4; ++n) s[n] = __builtin_amdgcn_mfma_f32_16x16x32_bf16(qf[ks], kf[ks & 1][n], s[n], 0, 0, 0);
              __builtin_amdgcn_sched_barrier(0);
          } }
        if constexpr (decltype(masktag)::value) {
        const int kbase = kt * 64 + fr;
#pragma unroll
        for (int j = 0; j < 4; ++j) {
            const int qi = q_idx0 + wave * 16 + fq * 4 + j;
            float tmax = -1e30f;
#pragma unroll
            for (int n = 0; n < 4; ++n) { const int delta = qi - (kbase + n * 16); const bool valid = (unsigned)delta <= (unsigned)maxdelta;
                const float sv = valid ? s[n][j] - bslope * (float)delta : -1e30f; s[n][j] = sv; tmax = fmaxf(tmax, sv); }
            tmax = row16_max(tmax);
            const float mn = fmaxf(m_run[j], tmax), alpha = __builtin_amdgcn_exp2f(m_run[j] - mn);
            m_run[j] = mn;
            float psum = 0.f;
#pragma unroll
            for (int n = 0; n < 4; ++n) { const float p = s[n][j] > -1e29f ? __builtin_amdgcn_exp2f(s[n][j] - mn) : 0.f; psum += p;
                *(LAS bf16_t*)(Pw + ((fq * 4 + j) * 72 + n * 16 + fr) * 2) = f2bf(p); }
            l_run[j] = l_run[j] * alpha + psum;
#pragma unroll
            for (int d = 0; d < 8; ++d) o[d][j] *= alpha;
        }
        } else {
            float mn[4];
#pragma unroll
            for (int j = 0; j < 4; ++j) { float tmax = fmaxf(fmaxf(s[0][j], s[1][j]), fmaxf(s[2][j], s[3][j])); tmax = row16_max(tmax); mn[j] = fmaxf(m_run[j], tmax); }
#pragma unroll
            for (int j = 0; j < 4; ++j) { const float alpha = __builtin_amdgcn_exp2f(m_run[j] - mn[j]); m_run[j] = mn[j];
                float psum = 0.f;
#pragma unroll
                for (int n = 0; n < 4; ++n) { const float p = __builtin_amdgcn_exp2f(s[n][j] - mn[j]); psum += p;
                    *(LAS bf16_t*)(Pw + ((fq * 4 + j) * 72 + n * 16 + fr) * 2) = f2bf(p); }
                l_run[j] = l_run[j] * alpha + psum;
#pragma unroll
                for (int d = 0; d < 8; ++d) o[d][j] *= alpha; }
        }
        LDS_FENCE();
        { bf16x8 pf[2], vf[2][4];
          const LAS unsigned char* vbase_p = Vb + cur * VBYTES + (fr * 72 + fq * 8) * 2;
          pf[0] = *(const LAS bf16x8*)(Pw + (fr * 72 + fq * 8) * 2); pf[1] = *(const LAS bf16x8*)(Pw + (fr * 72 + 32 + fq * 8) * 2);
#pragma unroll
          for (int d4 = 0; d4 < 4; ++d4) vf[0][d4] = *(const LAS bf16x8*)(vbase_p + (d4 * 16 * 72) * 2);
#pragma unroll
          for (int gI = 0; gI < 4; ++gI) {
              if (gI + 1 < 4) {
#pragma unroll
                  for (int d4 = 0; d4 < 4; ++d4) vf[(gI + 1) & 1][d4] = *(const LAS bf16x8*)(vbase_p + ((((gI + 1) & 1) * 4 + d4) * 16 * 72 + ((gI + 1) >> 1) * 32) * 2); }
              __builtin_amdgcn_sched_barrier(0);
#pragma unroll
              for (int d4 = 0; d4 < 4; ++d4) o[(gI & 1) * 4 + d4] = __builtin_amdgcn_mfma_f32_16x16x32_bf16(pf[gI >> 1], vf[gI & 1][d4], o[(gI & 1) * 4 + d4], 0, 0, 0);
              __builtin_amdgcn_sched_barrier(0);
          } }
        if (kt + 1 < kt_hi) ATT_STORE(cur ^ 1);
        __syncthreads();
    };
    { const int kt_int = (maxdelta < (1 << 29)) ? kt_lo : min(kt_hi, max(kt_lo, q_idx0 >> 6));
      for (int kt = kt_lo; kt < kt_int; ++kt) tile_step(std::integral_constant<bool, false>{}, kt);
      for (int kt = kt_int; kt < kt_hi; ++kt) tile_step(std::integral_constant<bool, true>{}, kt); }
#undef ATT_LOAD
#undef ATT_STORE
    const int L = SEQ >> dsh;
#pragma unroll
    for (int j = 0; j < 4; ++j) {
        float lt = l_run[j]; lt += __shfl_xor(lt, 1); lt += __shfl_xor(lt, 2); lt += __shfl_xor(lt, 4); lt += __shfl_xor(lt, 8);
        const float inv = lt > 0.f ? 1.f / lt : 0.f, lse = lt > 0.f ? (m_run[j] + __log2f(lt)) * 0.6931471805599453f : -1e30f;
        const int p = q_idx0 + wave * 16 + fq * 4 + j, r = p / L, m = p - r * L, srow = (m << dsh) + r;
        bf16_t* orow = Op + (size_t)srow * 512 + head * 128 + fr;
#pragma unroll
        for (int d = 0; d < 8; ++d) orow[d * 16] = f2bf(o[d][j] * inv);
        if (fr == 0) Lp[srow * 4 + head] = lse;
    }
}

__device__ __forceinline__ f32x4 ld4bf(const bf16_t* p) { const u32x2 u = *(const u32x2*)p; return (f32x4){bflo(u.x), bfhi(u.x), bflo(u.y), bfhi(u.y)}; }
__device__ __forceinline__ void phase_combine(KP P) {
    const bf16_t* proj = (const bf16_t*)(P->ws + W_PROJ);
    bf16_t* ys = (bf16_t*)(P->ws + W_YS);
    const bf16_t* oA = (const bf16_t*)(P->ws + W_OA); const float* lA = (const float*)(P->ws + W_LSEA);
    const bf16_t* oB = (const bf16_t*)(P->ws + W_OB); const float* lB = (const float*)(P->ws + W_LSEB);
    const int tid = fresh_tid(), skip = gridDim.x > 128 ? 64 : 0;
    if ((int)blockIdx.x < skip) return;
    for (int idx = ((int)blockIdx.x - skip) * 512 + tid; idx < SEQ * 256; idx += ((int)gridDim.x - skip) * 512) {
        const int s = idx >> 8, cg4 = idx & 255, br = cg4 >> 7, c4 = (cg4 & 127) * 4, j = c4 >> 7;
        f32x4 o; u32x2 zz;
        if (br == 0) {
            const float l0 = lA[s * 4 + j], l1 = lA[(SEQ + s) * 4 + j], l2 = lA[(2 * SEQ + s) * 4 + j];
            const float mx = fmaxf(l0, fmaxf(l1, l2)); const float w0 = __expf(l0 - mx), w1 = __expf(l1 - mx), w2 = __expf(l2 - mx); const float inv = 1.f / (w0 + w1 + w2);
            const f32x4 a = ld4bf(oA + (size_t)s * 512 + c4), b = ld4bf(oA + ((size_t)SEQ + s) * 512 + c4), c = ld4bf(oA + ((size_t)2 * SEQ + s) * 512 + c4);
            o = (a * w0 + b * w1 + c * w2) * inv;
            zz = *(const u32x2*)(proj + (size_t)s * NP + O_AZ + c4);
        } else {
            const float l0 = lB[s * 4 + j], l1 = lB[(SEQ + s) * 4 + j];
            const float mx = fmaxf(l0, l1); const float w0 = __expf(l0 - mx), w1 = __expf(l1 - mx); const float inv = 1.f / (w0 + w1);
            const f32x4 a = ld4bf(oB + (size_t)s * 512 + c4), b = ld4bf(oB + ((size_t)SEQ + s) * 512 + c4);
            o = (a * w0 + b * w1) * inv;
            zz = *(const u32x2*)(proj + (size_t)s * NP + O_BZ + c4);
        }
        u32x2 w; w.x = cvt_pk_bf16(o[0] * siluf_(bflo(zz.x)), o[1] * siluf_(bfhi(zz.x))); w.y = cvt_pk_bf16(o[2] * siluf_(bflo(zz.y)), o[3] * siluf_(bfhi(zz.y)));
        *(u32x2*)(ys + (size_t)s * DM + br * 512 + c4) = w;
    }
}

#define XB_TMO      128
#define XB_XCNT(j)  (256  + 64 * (j))
#define XB_XSUB(j)  (1280 + 64 * (j))
#define XB_XGEN(j)  (2304 + 64 * (j))
#define XB_TOP      3328
#define XB_TOPGEN   3392
#define XCD_BAR_WORDS 3456
#define XB_SPIN_CAP (1u << 20)
__device__ __forceinline__ unsigned xb_ld(unsigned* p)              { return __hip_atomic_load(p, __ATOMIC_RELAXED, __HIP_MEMORY_SCOPE_AGENT); }
__device__ __forceinline__ unsigned xb_add(unsigned* p, unsigned v) { return __hip_atomic_fetch_add(p, v, __ATOMIC_RELAXED, __HIP_MEMORY_SCOPE_AGENT); }
__device__ __forceinline__ unsigned xb_xcc_id() { return (unsigned)__builtin_amdgcn_s_getreg((3 << 11) | 20) & 0xFu; }
#define XB_SPIN(cond, bar) do { unsigned _sp = 0; while (cond) { __builtin_amdgcn_s_sleep(1); \
    if ((++_sp & 255u) == 0u) { if (xb_ld(&(bar)[XB_TMO])) break; if (_sp > XB_SPIN_CAP) { atomicAdd(&(bar)[XB_TMO], 1u); break; } } } } while (0)
struct XcdBarrier { unsigned* bar; unsigned x; volatile LAS unsigned* st; };
__device__ __forceinline__ XcdBarrier xcd_barrier_post(unsigned* bar, volatile LAS unsigned* st) {
    XcdBarrier b; b.bar = bar; b.x = xb_xcc_id(); b.st = st;
    if (threadIdx.x == 0) (void)xb_add(&bar[XB_XCNT(b.x)], 1u);
    return b;
}
__device__ __forceinline__ void xcd_barrier_complete(unsigned* bar, unsigned x, unsigned& nloc, unsigned& nx) {
    const unsigned G = gridDim.x * gridDim.y * gridDim.z;
    unsigned sum, cnt, mine, sp = 0u;
    for (;;) {
        sum = 0u; cnt = 0u; mine = 0u;
#pragma unroll
        for (unsigned j = 0; j < 16; ++j) { const unsigned c = xb_ld(&bar[XB_XCNT(j)]); sum += c; cnt += (c > 0u) ? 1u : 0u; mine = (j == x) ? c : mine; }
        if (sum == G) break;
        __builtin_amdgcn_s_sleep(1);
        if ((++sp & 255u) == 0u) { if (xb_ld(&bar[XB_TMO])) break; if (sp > XB_SPIN_CAP) { atomicAdd(&bar[XB_TMO], 1u); break; } }
    }
    nloc = mine > 0u ? mine : 1u; nx = cnt > 0u ? cnt : 1u;
}
__device__ __forceinline__ void xcd_barrier(const XcdBarrier& b) {
    asm volatile("s_waitcnt vmcnt(0)" ::: "memory");
    __syncthreads();
    if (threadIdx.x == 0) {
        unsigned* bar = b.bar;
        __builtin_amdgcn_s_waitcnt(0);
        unsigned nloc = b.st[0], nx = b.st[1];
        if (nloc == 0u) { xcd_barrier_complete(bar, b.x, nloc, nx); b.st[0] = nloc; b.st[1] = nx; }
        const unsigned old = xb_add(&bar[XB_XSUB(b.x)], 1u);
        const unsigned gen = old / nloc;
        if (old + 1u == (gen + 1u) * nloc) {
            __builtin_amdgcn_fence(__ATOMIC_RELEASE, "agent");
            asm volatile("s_waitcnt vmcnt(0)" ::: "memory");
            const unsigned og = xb_add(&bar[XB_TOP], 1u);
            const unsigned tg = og / nx;
            if (og + 1u == (tg + 1u) * nx) xb_add(&bar[XB_TOPGEN], 1u);
            else XB_SPIN(xb_ld(&bar[XB_TOPGEN]) == tg, bar);
            __builtin_amdgcn_fence(__ATOMIC_ACQUIRE, "agent");
            xb_add(&bar[XB_XGEN(b.x)], 1u);
            asm volatile("s_waitcnt vmcnt(0)" ::: "memory");
        } else {
            XB_SPIN(xb_ld(&bar[XB_XGEN(b.x)]) == gen, bar);
            __builtin_amdgcn_fence(__ATOMIC_ACQUIRE, "agent");
            asm volatile("s_waitcnt vmcnt(0)" ::: "memory");
        }
    }
    __syncthreads();
}

__global__ void __launch_bounds__(512, 2) fwd_mega(Params Pk) {
    extern __shared__ __attribute__((aligned(16))) unsigned char shm[];
    LAS unsigned char* lds = (LAS unsigned char*)shm;
    cg::grid_group grid = cg::this_grid();
    const int G = gridDim.x, bid = blockIdx.x, ngw = G * 8;
    volatile LAS unsigned* xst = (volatile LAS unsigned*)(lds + LDS_BYTES - 16);
    if (threadIdx.x == 0) { xst[0] = 0u; xst[1] = 0u; }
    __syncthreads();
    const XcdBarrier xb = xcd_barrier_post((unsigned*)(fresh_params()->ws + W_BAR), xst);
#define GSYNC() xcd_barrier(xb)
    for (int rp = 0; rp < REP_W; ++rp) { KP P = fresh_params(); phase_weights(P, lds); }
    for (int l = 0; l < DEPTH; ++l) {
        for (int rp = 0; rp < REP_P1; ++rp) { KP P = fresh_params(); const float* xin = l == 0 ? P->in[0] : P->out; phase_norm(xin, P->in[2] + l * DM, (bf16_t*)(P->ws + W_H)); }
        if (l == 0) grid.sync(); else GSYNC();
        for (int rp = 0; rp < REP_P2; ++rp) { KP P = fresh_params(); bf16_t* proj = (bf16_t*)(P->ws + W_PROJ); pg8::Gemm g{(const bf16_t*)(P->ws + W_H), (const bf16_t*)(P->ws + W_WIN + l * SZ_WIN), SEQ, NP, DM};
          pg8::StaticOrder S; S.init(SEQ, NP, G, bid);
          EpiProj E{proj, P->in[27] + l * 4 * DM};
          pg8::gemm_phase(lds, g, S, E); GSYNC(); }
        for (int rp = 0; rp < REP_P3; ++rp) { KP P = fresh_params();
        { const int tid = fresh_tid(), lane = tid & 63, gw = bid * 8 + (tid >> 6); for (int r2 = 0; r2 < REP_A; ++r2) for (int it = gw; it < 1536; it += ngw) a_prep_item(P, l, it, lane, lds + (tid >> 6) * 16384); }
        { const int tid = fresh_tid(), lane = tid & 63, gw = bid * 8 + (tid >> 6); for (int it = gw; it < SEQ; it += ngw) b_prep1_cq(P, l, it, lane); for (int it = gw; it < SEQ / 4; it += ngw) b_prep1_ckv(P, l, it, lane); }
        { const int tid = fresh_tid(), lane = tid & 63, gw = bid * 8 + (tid >> 6); for (int r2 = 0; r2 < REP_D1; ++r2) for (int it = gw; it < 4096; it += ngw) s5_item<false>(P, l, it, lane, lds + (tid >> 6) * 12800); }
        __syncthreads();
        for (int it = bid; it < 512; it += G) c1_item(P, l, it, lds); GSYNC(); }
        for (int rp = 0; rp < REP_P4; ++rp) { KP P = fresh_params(); const int scanW = 32, gemmW = G - scanW;
          if (bid < gemmW) {
              { pg8::Gemm g{(const bf16_t*)(P->ws + W_CQN), (const bf16_t*)(P->ws + W_WUQ + l * SZ_WUQ), SEQ, 768, 512};
                pg8::StaticOrder S; S.init(SEQ, 768, gemmW, bid); EpiBf16 E{(bf16_t*)(P->ws + W_QRAW), 768}; pg8::gemm_phase(lds, g, S, E); }
              { pg8::Gemm g{(const bf16_t*)(P->ws + W_CKVN), (const bf16_t*)(P->ws + W_WUKV + l * SZ_WUKV), SEQ, 1024, 256};
                pg8::StaticOrder S; S.init(SEQ, 1024, gemmW, (bid + gemmW - 96) % gemmW); EpiKV E{(bf16_t*)(P->ws + W_KVRAW), (bf16_t*)(P->ws + W_VBT)}; pg8::gemm_phase(lds, g, S, E); }
          } else {
              const int tid = fresh_tid(), nst = scanW * 512;
              LAS float* metaL = (LAS float*)lds;
              for (int i = tid; i < 1024; i += 512) metaL[i] = ((const float*)(P->ws + W_META))[i];
              __syncthreads();
              { const int e = (bid - gemmW - (scanW - 4)) * 512 + tid; if (e >= 0 && e < 2048) d2_elem(P, l, e); }
              c2_multi(P, (bid - gemmW) * 512 + tid, nst, metaL);
          }
          __syncthreads();
          unsigned* ticket = (unsigned*)(P->ws + W_BAR + 14336) + l * 64;
          volatile LAS int* tk = (volatile LAS int*)(lds + LDS_BYTES - 32);
          for (;;) {
              if (threadIdx.x == 0) tk[0] = (int)atomicAdd(ticket, 1u);
              __syncthreads();
              const int it = tk[0];
              __syncthreads();
              if (it >= 768) break;
              const int hh = it >> 6, nq = it & 63, g = hh >> 2, dsh = 2 * g, L = SEQ >> dsh, p0 = nq * 128, n_in = (p0 & (L - 1)) >> 7;
              const int kt_hi = p0 / 64 + 2, kt_lo = n_in == 0 ? p0 / 64 : p0 / 64 - 2;
              const float slope = exp2f(-8.f * (float)(hh + 1) / 12.f) * (float)(1 << dsh) * 1.4426950408889634f;
              attn_block<128>(lds, (const bf16_t*)(P->ws + W_QA) + ((size_t)hh * SEQ + p0) * 128, (const bf16_t*)(P->ws + W_KA) + (size_t)hh * SEQ * 128,
                              (const bf16_t*)(P->ws + W_VAT) + (size_t)hh * 128 * SEQ, p0, kt_lo, kt_hi, 128, slope, dsh,
                              (bf16_t*)(P->ws + W_OA) + (size_t)g * SEQ * 512, (float*)(P->ws + W_LSEA) + (size_t)g * SEQ * 4, hh & 3);
          } GSYNC(); }
        for (int rp = 0; rp < REP_P5; ++rp) { KP P = fresh_params();
        { const int tid = fresh_tid(), lane = tid & 63, gw = bid * 8 + (tid >> 6); for (int it = gw; it < SEQ; it += ngw) b_prep2_item(P, l, it, lane); }
        { const int tid = fresh_tid(), lane = tid & 63, gw = bid * 8 + (tid >> 6); for (int r2 = 0; r2 < REP_D3; ++r2) for (int it = gw; it < 4096; it += ngw) s5_item<true>(P, l, it, lane, lds + (tid >> 6) * 12800); }
        __syncthreads();
        for (int r2 = 0; r2 < REP_C3; ++r2) for (int it = bid; it < 512; it += G) c3_item(P, l, it, lds); GSYNC(); }
        for (int rp = 0; rp < REP_P6; ++rp) {
        for (int slot = bid; slot < 256; slot += G) { KP P = fresh_params();
            const int h = slot & 3, part = (slot >> 2) & 1, i0 = slot >> 3;
#pragma unroll 1
            for (int rep = 0; rep < 2; ++rep) {
                const int i = rep ? 63 - i0 : i0, nkb = i + 1, h0 = (nkb + 1) >> 1;
                const int kt_lo = part ? 2 * h0 : 0, kt_hi = part ? 2 * nkb : 2 * h0;
                attn_block<192>(lds, (const bf16_t*)(P->ws + W_QB) + ((size_t)h * SEQ + i * 128) * 192, (const bf16_t*)(P->ws + W_KB) + (size_t)h * SEQ * 192,
                                (const bf16_t*)(P->ws + W_VBT) + (size_t)h * 128 * SEQ, i * 128, kt_lo, kt_hi, 1 << 30, 0.f, 0,
                                (bf16_t*)(P->ws + W_OB) + (size_t)part * SEQ * 512, (float*)(P->ws + W_LSEB) + (size_t)part * SEQ * 4, h);
            }
        }
        GSYNC(); }
        for (int rp = 0; rp < REP_P7; ++rp) {
        { KP P = fresh_params(); bf16_t* proj = (bf16_t*)(P->ws + W_PROJ); pg8::Gemm g{(const bf16_t*)(P->ws + W_YD), (const bf16_t*)(P->ws + W_WGLU + l * SZ_WGLU), SEQ, 512, 512};
          pg8::StaticOrder S; S.init(SEQ, 512, G, bid);
          EpiGlu E{(const bf16_t*)(P->ws + W_YD), proj, P->in[25] + l * 512, (bf16_t*)(P->ws + W_YS)};
          pg8::gemm_phase(lds, g, S, E); }
        { KP P = fresh_params(); phase_combine(P); }
        GSYNC(); }
        for (int rp = 0; rp < REP_P8; ++rp) { KP P = fresh_params(); bf16_t* proj = (bf16_t*)(P->ws + W_PROJ); pg8::Gemm g{(const bf16_t*)(P->ws + W_YS), (const bf16_t*)(P->ws + W_WUP + l * SZ_WSQ), SEQ, DM, DM};
          pg8::StaticOrder S; S.init(SEQ, DM, G, bid);
          EpiUp E{proj, (bf16_t*)(P->ws + W_MERGED)};
          pg8::gemm_phase(lds, g, S, E); GSYNC(); }
        for (int rp = 0; rp < REP_SYNC; ++rp) GSYNC();
        for (int rp = 0; rp < (l == 0 ? REP_P9 : 1); ++rp) { KP P = fresh_params(); const float* xin = l == 0 ? P->in[0] : P->out; pg8::Gemm g{(const bf16_t*)(P->ws + W_MERGED), (const bf16_t*)(P->ws + W_WOUT + l * SZ_WSQ), SEQ, DM, DM};
          pg8::StaticOrder S; S.init(SEQ, DM, G, bid);
          EpiOut E{xin, P->out};
          pg8::gemm_phase(lds, g, S, E); GSYNC(); }
    }
}

extern "C" void kernel_launch(void* const* d_in, const int* in_sizes, int n_in, void* d_out, int out_size, void* d_ws, size_t ws_size, hipStream_t stream) {
    static int grid_blocks = 0;
    if (!grid_blocks) {
        int dev = 0, cus = 0, per_cu = 0;
        (void)hipGetDevice(&dev);
        (void)hipDeviceGetAttribute(&cus, hipDeviceAttributeMultiprocessorCount, dev);
        (void)hipFuncSetAttribute((const void*)fwd_mega, hipFuncAttributeMaxDynamicSharedMemorySize, LDS_BYTES);
        (void)hipOccupancyMaxActiveBlocksPerMultiprocessor(&per_cu, (const void*)fwd_mega, 512, LDS_BYTES);
        (void)hipGetLastError();
        grid_blocks = cus > 0 ? cus : 256;
        if (ws_size < W_END) fprintf(stderr, "workspace too small: %zu < %zu\n", ws_size, (size_t)W_END);
        fprintf(stderr, "grid %d (cus %d per_cu %d)\n", grid_blocks, cus, per_cu);
    }
    (void)hipMemsetAsync((unsigned char*)d_ws + W_BAR, 0, 16384, stream);
    Params p{};
    for (int i = 0; i < 29; ++i) p.in[i] = (const float*)d_in[i];
    p.out = (float*)d_out; p.ws = (unsigned char*)d_ws;
    void* args[] = {&p};
    hipError_t e = hipLaunchCooperativeKernel((const void*)fwd_mega, dim3(grid_blocks), dim3(512), args, LDS_BYTES, stream);
    if (e != hipSuccess) fprintf(stderr, "cooperative launch failed: %s\n", hipGetErrorString(e));
}
```

```cpp
#include <hip/hip_runtime.h>
#include <hip/hip_cooperative_groups.h>
#include <cstdio>
#include <type_traits>
namespace cg = cooperative_groups;

#define LAS __attribute__((address_space(3)))
typedef unsigned short bf16_t;
typedef short bf16x8 __attribute__((ext_vector_type(8)));
typedef float f32x4 __attribute__((ext_vector_type(4)));
typedef unsigned u32x4 __attribute__((ext_vector_type(4)));
typedef unsigned u32x2 __attribute__((ext_vector_type(2)));

constexpr int SEQ = 8192, DM = 2048, NIN = 17544, NP = 17664, NG0 = 9352, GATE0 = 9472, DEPTH = 4;
constexpr int O_AQ = 0, O_AK = 1536, O_AV = 3072, O_AZ = 4608, O_BCQ = 5120, O_BCKV = 5568, O_BKR = 5696, O_BZ = 5760, O_CQK = 6272,
              O_CV = 6784, O_CI = 7296, O_CF = 7300, O_CO = 7304, O_CZ = 7816, O_DU = 8328, O_DZ = 8840;
constexpr float EPS = 1e-6f;
constexpr int LDS_BYTES = 144 * 1024;
#define REP_W 1
#define REP_P1 1
#define REP_SYNC 0
#define REP_P9 1
#define REP_A 1
#define REP_D1 1
#define REP_D3 1
#define REP_C3 1
#define REP_P2 1
#define REP_P3 1
#define REP_P4 1
#define REP_P5 1
#define REP_P6 1
#define REP_P7 1
#define REP_P8 1

constexpr size_t al(size_t x) { return (x + 255) & ~(size_t)255; }
constexpr size_t SZ_WIN = (size_t)NP * DM * 2, SZ_WSQ = (size_t)DM * DM * 2, SZ_WUQ = (size_t)768 * 512 * 2, SZ_WUKV = (size_t)1024 * 256 * 2, SZ_WGLU = (size_t)512 * 512 * 2;
constexpr size_t W_WIN = 0;
constexpr size_t W_WUP = W_WIN + DEPTH * SZ_WIN;
constexpr size_t W_WOUT = W_WUP + DEPTH * SZ_WSQ;
constexpr size_t W_WUQ = W_WOUT + DEPTH * SZ_WSQ;
constexpr size_t W_WUKV = W_WUQ + DEPTH * SZ_WUQ;
constexpr size_t W_WGLU = W_WUKV + DEPTH * SZ_WUKV;
constexpr size_t W_H = W_WGLU + DEPTH * SZ_WGLU;
constexpr size_t W_PROJ = W_H + (size_t)SEQ * DM * 2;
constexpr size_t W_QA = W_PROJ + (size_t)SEQ * NP * 2;
constexpr size_t W_KA = W_QA + (size_t)12 * SEQ * 128 * 2;
constexpr size_t W_VAT = W_KA + (size_t)12 * SEQ * 128 * 2;
constexpr size_t W_CQN = W_VAT + (size_t)12 * SEQ * 128 * 2;
constexpr size_t W_CKVN = W_CQN + (size_t)SEQ * 512 * 2;
constexpr size_t W_QRAW = W_CKVN + (size_t)SEQ * 256 * 2;
constexpr size_t W_KVRAW = W_QRAW + (size_t)SEQ * 768 * 2;
constexpr size_t W_QB = W_KVRAW + (size_t)SEQ * 1024 * 2;
constexpr size_t W_KB = W_QB + (size_t)4 * SEQ * 192 * 2;
constexpr size_t W_VBT = W_KB + (size_t)4 * SEQ * 192 * 2;
constexpr size_t W_OA = W_VBT + (size_t)4 * 128 * SEQ * 2;
constexpr size_t W_LSEA = W_OA + (size_t)3 * SEQ * 512 * 4;
constexpr size_t W_OB = W_LSEA + (size_t)3 * SEQ * 4 * 4;
constexpr size_t W_LSEB = W_OB + (size_t)2 * SEQ * 512 * 4;
constexpr size_t W_CLOC = W_LSEB + (size_t)2 * SEQ * 4 * 4;
constexpr size_t W_CST = W_CLOC + (size_t)512 * 8192 * 4;
constexpr size_t W_NLOC = W_CST + (size_t)512 * 8192 * 4;
constexpr size_t W_NST = W_NLOC + (size_t)512 * 64 * 4;
constexpr size_t W_META = W_NST + (size_t)512 * 64 * 4;
constexpr size_t W_MST = W_META + al(512 * 2 * 4);
constexpr size_t W_XEND = W_MST + al(512 * 4);
constexpr size_t W_XST = W_XEND + (size_t)128 * 2048 * 2 * 4;
constexpr size_t W_YD = W_XST + (size_t)128 * 2048 * 2 * 4;
constexpr size_t W_YS = W_YD + (size_t)SEQ * 512 * 2;
constexpr size_t W_MERGED = W_YS + (size_t)SEQ * DM * 2;
constexpr size_t W_BAR = W_MERGED + (size_t)SEQ * DM * 2;
constexpr size_t W_END = W_BAR + 16384;

struct Params { const float* in[29]; float* out; unsigned char* ws; };
typedef const Params __attribute__((address_space(4))) * KP;
__device__ __forceinline__ KP fresh_params() { KP p = (KP)__builtin_amdgcn_kernarg_segment_ptr(); asm volatile("" : "+s"(p)); return p; }

__device__ __forceinline__ float bflo(unsigned u) { return __uint_as_float(u << 16); }
__device__ __forceinline__ float bfhi(unsigned u) { return __uint_as_float(u & 0xffff0000u); }
__device__ __forceinline__ float bf2f(bf16_t b) { return __uint_as_float(((unsigned)b) << 16); }
__device__ __forceinline__ unsigned cvt_pk_bf16(float lo, float hi) { unsigned r; asm volatile("s_nop 0\n\tv_cvt_pk_bf16_f32 %0, %1, %2" : "=v"(r) : "v"(lo), "v"(hi)); return r; }
__device__ __forceinline__ bf16_t f2bf(float f) { return (bf16_t)(cvt_pk_bf16(f, 0.f) & 0xffffu); }
__device__ __forceinline__ void ld8(const bf16_t* p, float (&v)[8]) {
    const u32x4 u = *(const u32x4*)p;
    v[0] = bflo(u.x); v[1] = bfhi(u.x); v[2] = bflo(u.y); v[3] = bfhi(u.y); v[4] = bflo(u.z); v[5] = bfhi(u.z); v[6] = bflo(u.w); v[7] = bfhi(u.w);
}
__device__ __forceinline__ void st8(bf16_t* p, const float (&v)[8]) {
    u32x4 u; u.x = cvt_pk_bf16(v[0], v[1]); u.y = cvt_pk_bf16(v[2], v[3]); u.z = cvt_pk_bf16(v[4], v[5]); u.w = cvt_pk_bf16(v[6], v[7]);
    *(u32x4*)p = u;
}
__device__ __forceinline__ float sigmoidf_(float x) { return __builtin_amdgcn_rcpf(1.f + __expf(-x)); }
__device__ __forceinline__ float siluf_(float x) { return x * sigmoidf_(x); }
__device__ __forceinline__ float wave_sum(float v) {
#pragma unroll
    for (int o = 1; o < 64; o <<= 1) v += __shfl_xor(v, o);
    return v;
}
__device__ __forceinline__ float wave_max(float v) {
#pragma unroll
    for (int o = 1; o < 64; o <<= 1) v = fmaxf(v, __shfl_xor(v, o));
    return v;
}
__device__ __forceinline__ int fresh_tid() { int t = threadIdx.x; asm volatile("" : "+v"(t)); return t; }
template <int CTRL> __device__ __forceinline__ float dppf(float v) { return __int_as_float(__builtin_amdgcn_update_dpp(0, __float_as_int(v), CTRL, 0xf, 0xf, true)); }
__device__ __forceinline__ float row16_max(float v) { v = fmaxf(v, dppf<0x128>(v)); v = fmaxf(v, dppf<0x124>(v)); v = fmaxf(v, dppf<0x122>(v)); v = fmaxf(v, dppf<0x121>(v)); return v; }
__device__ __forceinline__ float row16_sum(float v) { v += dppf<0x128>(v); v += dppf<0x124>(v); v += dppf<0x122>(v); v += dppf<0x121>(v); return v; }
#define LDS_FENCE() asm volatile("s_waitcnt lgkmcnt(0)" ::: "memory")

namespace pg8 {
constexpr int BM = 256, BK = 64, HALF = 128, HTB = HALF * BK * 2, STAGE_BYTES = 8 * HTB, NXCD = 8, WGM = 4;
__device__ __forceinline__ int lds_byte(int r, int c) { const int st = (r >> 4) * 2 + (c >> 5), rr = r & 15, cc = c & 31, ob = rr * 64 + cc * 2; return st * 1024 + (ob ^ (((ob >> 9) & 1) << 5)); }
__device__ __forceinline__ void stage_rc(int b, int& R, int& C) { const int st = b / 1024, sb = b % 1024, swz = sb ^ (((sb >> 9) & 1) << 5); R = (st >> 1) * 16 + swz / 64; C = (st & 1) * 32 + (swz % 64) / 2; }
__device__ __forceinline__ int perm32(int rho) { const int n = rho >> 4, i = rho & 15; return 8 * (i >> 2) + 4 * n + (i & 3); }
struct Unit { int pm, pn; };
struct Gemm { const bf16_t* A; const bf16_t* Bt; int M, N, K; };
struct StaticOrder {
    int nM, nN, nwg, G, c;
    __device__ void init(int M, int N, int G_, int c_) { nM = M / BM; nN = N / BM; nwg = nM * nN; G = G_; c = c_; }
    __device__ bool next(int i, Unit& u) const {
        const long L = (long)i * G + c; if (L >= nwg) return false;
        int wgid = (int)L; { const int q = nwg / NXCD, r = nwg % NXCD, xcd = wgid % NXCD, off = wgid / NXCD; wgid = (xcd < r ? xcd * (q + 1) : r * (q + 1) + (xcd - r) * q) + off; }
        const int nig = WGM * nN, gid = wgid / nig, fm = gid * WGM, gsz = (nM - fm) < WGM ? (nM - fm) : WGM;
        u.pm = fm + ((wgid % nig) % gsz); u.pn = (wgid % nig) / gsz; return true;
    }
};

template <class Epi>
__device__ __forceinline__ void gemm_phase(LAS unsigned char* lds, const Gemm g, const StaticOrder& S, const Epi& E) {
    const int tid = fresh_tid(), wid = __builtin_amdgcn_readfirstlane(tid >> 6), lane = tid & 63, wr = wid >> 2, wc = wid & 3, fr = lane & 15, fq = lane >> 4;
    const int K = g.K, nt = K / BK;
    unsigned voffA[2], voffB[2];
#pragma unroll
    for (int i = 0; i < 2; ++i) { int R, C; stage_rc(tid * 16 + i * 8192, R, C); const int Rb = Epi::PERM ? ((R & ~31) + perm32(R & 31)) : R;
        voffA[i] = (unsigned)(R * K + C) * 2u; voffB[i] = (unsigned)(Rb * K + C) * 2u; }
    const size_t kstep = (size_t)(BK * 2);
    const size_t hstep = (size_t)HALF * K * 2;
    const size_t tstep = 2 * hstep;
    const unsigned ldsw = (unsigned)wid * 1024u;
    const int aoff = lds_byte(wr * 64 + fr, fq * 8), boff = lds_byte(wc * 32 + fr, fq * 8);
#define PG8_SA(b, h) (((b) * 2 + (h)) * HTB)
#define PG8_SB(b, h) ((4 + (b) * 2 + (h)) * HTB)
#define PG8_STAGE_(bufoff, gbase, voff) do { _Pragma("unroll") for (int _i = 0; _i < 2; ++_i) \
        __builtin_amdgcn_global_load_lds((const unsigned*)((const char*)(gbase) + (voff)[_i]), (LAS unsigned*)(lds + (bufoff) + ldsw + _i * 8192), 16, 0, 0); } while (0)
#define PG8_STAGE(bufoff, gbase) PG8_STAGE_(bufoff, gbase, voffA)
#define PG8_STAGEB(bufoff, gbase) PG8_STAGE_(bufoff, gbase, voffB)
#define PG8_LDA(dst, b, h) do { _Pragma("unroll") for (int m = 0; m < 4; ++m) _Pragma("unroll") for (int k = 0; k < 2; ++k) dst[m][k] = *(const LAS bf16x8*)(lds + PG8_SA(b, h) + aoff + m * 2048 + k * 1024); } while (0)
#define PG8_LDB(dst, b, h) do { _Pragma("unroll") for (int n = 0; n < 2; ++n) _Pragma("unroll") for (int k = 0; k < 2; ++k) dst[n][k] = *(const LAS bf16x8*)(lds + PG8_SB(b, h) + boff + n * 2048 + k * 1024); } while (0)
#define PG8_MMA(ai, bj, At, Bt) do { __builtin_amdgcn_s_setprio(1); _Pragma("unroll") for (int m = 0; m < 4; ++m) _Pragma("unroll") for (int n = 0; n < 2; ++n) _Pragma("unroll") for (int k = 0; k < 2; ++k) \
        acc[ai][bj][m][n] = __builtin_amdgcn_mfma_f32_16x16x32_bf16(Bt[n][k], At[m][k], acc[ai][bj][m][n], 0, 0, 0); __builtin_amdgcn_s_setprio(0); } while (0)
#define PG8_WAIT_V(n) asm volatile("s_waitcnt vmcnt(" #n ")" ::: "memory")
#define PG8_WAIT_L(n) asm volatile("s_waitcnt lgkmcnt(" #n ")" ::: "memory")
#define PG8_BAR __builtin_amdgcn_s_barrier()
#define PG8_SCHED __builtin_amdgcn_sched_barrier(0)
    Unit cur, nxt; int ui = 0;
    if (!S.next(0, cur)) return;
    f32x4 acc[2][2][4][2];
#pragma unroll
    for (int a = 0; a < 2; ++a)
#pragma unroll
        for (int b = 0; b < 2; ++b)
#pragma unroll
            for (int m = 0; m < 4; ++m)
#pragma unroll
                for (int n = 0; n < 2; ++n) acc[a][b][m][n] = (f32x4){0.f, 0.f, 0.f, 0.f};
    bf16x8 At[4][2], B0[2][2], B1[2][2];
    const char* cA = (const char*)g.A + (size_t)cur.pm * tstep; const char* cB = (const char*)g.Bt + (size_t)cur.pn * tstep;
    PG8_STAGEB(PG8_SB(0, 0), cB); PG8_STAGE(PG8_SA(0, 0), cA); PG8_STAGEB(PG8_SB(0, 1), cB + hstep); PG8_STAGE(PG8_SA(0, 1), cA + hstep);
    if (wr == 1) PG8_BAR;
    PG8_WAIT_V(4); PG8_BAR;
    PG8_STAGEB(PG8_SB(1, 0), cB + kstep); PG8_STAGE(PG8_SA(1, 0), cA + kstep); PG8_STAGEB(PG8_SB(1, 1), cB + hstep + kstep);
    PG8_WAIT_V(6); PG8_BAR;
    for (;;) {
        const bool has_next = S.next(ui + 1, nxt);
        const char* nA = has_next ? (const char*)g.A + (size_t)nxt.pm * tstep : cA; const char* nB = has_next ? (const char*)g.Bt + (size_t)nxt.pn * tstep : cB;
        for (int t = 0; t < nt; t += 2) {
            const bool last = (t == nt - 2);
            const char* a1 = cA + (size_t)(t + 1) * kstep;
            const char* a2 = last ? nA : cA + (size_t)(t + 2) * kstep; const char* b2 = last ? nB : cB + (size_t)(t + 2) * kstep;
            const char* a3 = a2 + kstep; const char* b3 = b2 + kstep;
            if constexpr (Epi::RESCALE) { if (t != 0 && (t & 7) == 0) { const int t2 = fresh_tid(); const int w2 = __builtin_amdgcn_readfirstlane(t2 >> 6); E.rescale(acc, cur, t >> 3, w2 >> 2, w2 & 3, t2 & 15, (t2 >> 4) & 3); } }
            PG8_LDB(B0, 0, 0); PG8_SCHED; PG8_LDA(At, 0, 0); PG8_STAGE(PG8_SA(1, 1), a1 + hstep);
            PG8_WAIT_L(8); PG8_BAR; PG8_WAIT_L(0); PG8_MMA(0, 0, At, B0); PG8_BAR; PG8_SCHED;
            PG8_LDB(B1, 0, 1); PG8_STAGEB(PG8_SB(0, 0), b2);
            PG8_BAR; PG8_WAIT_L(0); PG8_MMA(0, 1, At, B1); PG8_BAR;
            PG8_LDA(At, 0, 1); PG8_STAGE(PG8_SA(0, 0), a2);
            PG8_BAR; PG8_WAIT_L(0); PG8_MMA(1, 0, At, B0); PG8_BAR; PG8_SCHED;
            PG8_STAGEB(PG8_SB(0, 1), b2 + hstep);
            PG8_WAIT_V(6); PG8_BAR; PG8_MMA(1, 1, At, B1); PG8_BAR;
            PG8_LDB(B0, 1, 0); PG8_SCHED; PG8_LDA(At, 1, 0); PG8_STAGE(PG8_SA(0, 1), a2 + hstep);
            PG8_WAIT_L(8); PG8_BAR; PG8_WAIT_L(0); PG8_MMA(0, 0, At, B0); PG8_BAR; PG8_SCHED;
            PG8_LDB(B1, 1, 1); PG8_STAGEB(PG8_SB(1, 0), b3);
            PG8_BAR; PG8_WAIT_L(0); PG8_MMA(0, 1, At, B1); PG8_BAR;
            PG8_LDA(At, 1, 1); PG8_STAGE(PG8_SA(1, 0), a3);
            PG8_BAR; PG8_WAIT_L(0); PG8_MMA(1, 0, At, B0); PG8_BAR; PG8_SCHED;
            PG8_STAGEB(PG8_SB(1, 1), b3 + hstep);
            PG8_WAIT_V(6); PG8_BAR; PG8_MMA(1, 1, At, B1); PG8_BAR;
        }
        { const int t2 = fresh_tid(); const int w2 = __builtin_amdgcn_readfirstlane(t2 >> 6); E(acc, cur, w2 >> 2, w2 & 3, t2 & 15, (t2 >> 4) & 3); }
        if (!has_next) break;
#pragma unroll
        for (int a = 0; a < 2; ++a)
#pragma unroll
            for (int b = 0; b < 2; ++b)
#pragma unroll
                for (int m = 0; m < 4; ++m)
#pragma unroll
                    for (int n = 0; n < 2; ++n) acc[a][b][m][n] = (f32x4){0.f, 0.f, 0.f, 0.f};
        cur = nxt; cA = nA; cB = nB; ++ui;
    }
    PG8_WAIT_V(0);
    if (wr == 0) PG8_BAR;
    PG8_BAR;
#undef PG8_SA
#undef PG8_SB
#undef PG8_STAGE
#undef PG8_STAGEB
#undef PG8_STAGE_
#undef PG8_LDA
#undef PG8_LDB
#undef PG8_MMA
#undef PG8_WAIT_V
#undef PG8_WAIT_L
#undef PG8_BAR
#undef PG8_SCHED
}
}
using pg8::Unit;
typedef f32x4 AccT[2][2][4][2];

struct EpiProj {
    static constexpr bool RESCALE = false, PERM = true;
    bf16_t* O; const float* mb;
    __device__ __forceinline__ void operator()(AccT& acc, const Unit& u, int wr, int wc, int fr, int fq) const {
        int row0 = u.pm * 256 + wr * 64 + fr, col0 = u.pn * 256 + wc * 32 + 8 * fq;
        asm volatile("" : "+v"(row0), "+v"(col0));
        const bool gate = u.pn >= 37;
        f32x4 bv[2][2];
#pragma unroll
        for (int bj = 0; bj < 2; ++bj)
#pragma unroll
            for (int n = 0; n < 2; ++n) bv[bj][n] = gate ? *(const f32x4*)(mb + (col0 - GATE0) + bj * 128 + n * 4) : (f32x4){0.f, 0.f, 0.f, 0.f};
#pragma unroll
        for (int ai = 0; ai < 2; ++ai)
#pragma unroll
            for (int m = 0; m < 4; ++m) { bf16_t* rowp = O + (size_t)(row0 + ai * 128 + m * 16) * NP + col0;
#pragma unroll
                for (int bj = 0; bj < 2; ++bj) { f32x4 v0 = acc[ai][bj][m][0], v1 = acc[ai][bj][m][1];
                    if (gate) { v0 = v0 + bv[bj][0]; v1 = v1 + bv[bj][1];
                        v0[0] = sigmoidf_(v0[0]); v0[1] = sigmoidf_(v0[1]); v0[2] = sigmoidf_(v0[2]); v0[3] = sigmoidf_(v0[3]);
                        v1[0] = sigmoidf_(v1[0]); v1[1] = sigmoidf_(v1[1]); v1[2] = sigmoidf_(v1[2]); v1[3] = sigmoidf_(v1[3]); }
                    u32x4 w; w.x = cvt_pk_bf16(v0[0], v0[1]); w.y = cvt_pk_bf16(v0[2], v0[3]); w.z = cvt_pk_bf16(v1[0], v1[1]); w.w = cvt_pk_bf16(v1[2], v1[3]);
                    __builtin_nontemporal_store(w, (u32x4*)(rowp + bj * 128)); } }
    }
};
struct EpiBf16 {
    static constexpr bool RESCALE = false, PERM = true;
    bf16_t* O; int ldc;
    __device__ __forceinline__ void operator()(AccT& acc, const Unit& u, int wr, int wc, int fr, int fq) const {
        int row0 = u.pm * 256 + wr * 64 + fr, col0 = u.pn * 256 + wc * 32 + 8 * fq;
        asm volatile("" : "+v"(row0), "+v"(col0));
#pragma unroll
        for (int ai = 0; ai < 2; ++ai)
#pragma unroll
            for (int m = 0; m < 4; ++m) { bf16_t* rowp = O + (size_t)(row0 + ai * 128 + m * 16) * ldc + col0;
#pragma unroll
                for (int bj = 0; bj < 2; ++bj) { const f32x4 v0 = acc[ai][bj][m][0], v1 = acc[ai][bj][m][1];
                    u32x4 w; w.x = cvt_pk_bf16(v0[0], v0[1]); w.y = cvt_pk_bf16(v0[2], v0[3]); w.z = cvt_pk_bf16(v1[0], v1[1]); w.w = cvt_pk_bf16(v1[2], v1[3]);
                    *(u32x4*)(rowp + bj * 128) = w; } }
    }
};
struct EpiKV {
    static constexpr bool RESCALE = false, PERM = true;
    bf16_t* O; bf16_t* VT;
    __device__ __forceinline__ void operator()(AccT& acc, const Unit& u, int wr, int wc, int fr, int fq) const {
        int row0 = u.pm * 256 + wr * 64 + fr, cl = wc * 32 + 8 * fq;
        asm volatile("" : "+v"(row0), "+v"(cl));
#pragma unroll
        for (int ai = 0; ai < 2; ++ai)
#pragma unroll
            for (int m = 0; m < 4; ++m) { const int row = row0 + ai * 128 + m * 16;
                { const f32x4 v0 = acc[ai][0][m][0], v1 = acc[ai][0][m][1];
                  u32x4 w; w.x = cvt_pk_bf16(v0[0], v0[1]); w.y = cvt_pk_bf16(v0[2], v0[3]); w.z = cvt_pk_bf16(v1[0], v1[1]); w.w = cvt_pk_bf16(v1[2], v1[3]);
                  *(u32x4*)(O + (size_t)row * 1024 + u.pn * 256 + cl) = w; }
#pragma unroll
                for (int n = 0; n < 2; ++n) { const f32x4 v = acc[ai][1][m][n];
                    const unsigned w0 = cvt_pk_bf16(v[0], v[1]), w1 = cvt_pk_bf16(v[2], v[3]);
                    bf16_t* vp = VT + (size_t)(u.pn * 128 + cl + n * 4) * SEQ + row;
                    vp[0] = (bf16_t)(w0 & 0xffffu); vp[SEQ] = (bf16_t)(w0 >> 16); vp[2 * SEQ] = (bf16_t)(w1 & 0xffffu); vp[3 * SEQ] = (bf16_t)(w1 >> 16); } }
    }
};
struct EpiGlu {
    static constexpr bool RESCALE = false, PERM = true;
    const bf16_t* yd; const bf16_t* proj; const float* gb; bf16_t* ys;
    __device__ __forceinline__ void operator()(AccT& acc, const Unit& u, int wr, int wc, int fr, int fq) const {
        int row0 = u.pm * 256 + wr * 64 + fr, col0 = u.pn * 256 + wc * 32 + 8 * fq;
        asm volatile("" : "+v"(row0), "+v"(col0));
#pragma unroll
        for (int ai = 0; ai < 2; ++ai)
#pragma unroll
            for (int m = 0; m < 4; ++m) { const size_t row = (size_t)(row0 + ai * 128 + m * 16);
#pragma unroll
                for (int bj = 0; bj < 2; ++bj) { const int c = col0 + bj * 128;
                    float y8[8], z8[8], o8[8]; ld8(yd + row * 512 + c, y8); ld8(proj + row * NP + O_DZ + c, z8);
                    const f32x4 b0 = *(const f32x4*)(gb + c), b1 = *(const f32x4*)(gb + c + 4);
#pragma unroll
                    for (int e = 0; e < 4; ++e) { o8[e] = y8[e] * sigmoidf_(acc[ai][bj][m][0][e] + b0[e]) * siluf_(z8[e]); o8[4 + e] = y8[4 + e] * sigmoidf_(acc[ai][bj][m][1][e] + b1[e]) * siluf_(z8[4 + e]); }
                    st8(ys + row * DM + 1536 + c, o8); } }
    }
};
struct EpiUp {
    static constexpr bool RESCALE = true, PERM = true;
    const bf16_t* proj; bf16_t* O;
    __device__ __forceinline__ void rescale(AccT& acc, const Unit& u, int k, int wr, int wc, int fr, int fq) const {
        int row0 = u.pm * 256 + wr * 64 + fr, col0 = u.pn * 256 + wc * 32 + 8 * fq;
        asm volatile("" : "+v"(row0), "+v"(col0));
#pragma unroll
        for (int ai = 0; ai < 2; ++ai)
#pragma unroll
            for (int m = 0; m < 4; ++m) { const bf16_t* gp = proj + (size_t)(row0 + ai * 128 + m * 16) * NP + GATE0 + (k - 1) * DM + col0;
#pragma unroll
                for (int bj = 0; bj < 2; ++bj) { float ga[8], gb[8]; ld8(gp + bj * 128, ga); ld8(gp + DM + bj * 128, gb);
                    f32x4 r0, r1;
#pragma unroll
                    for (int e = 0; e < 4; ++e) { r0[e] = ga[e] * __builtin_amdgcn_rcpf(fmaxf(gb[e], 1e-30f)); r1[e] = ga[4 + e] * __builtin_amdgcn_rcpf(fmaxf(gb[4 + e], 1e-30f)); }
                    acc[ai][bj][m][0] = acc[ai][bj][m][0] * r0; acc[ai][bj][m][1] = acc[ai][bj][m][1] * r1; }
                asm volatile("" ::: "memory"); }
    }
    __device__ __forceinline__ void operator()(AccT& acc, const Unit& u, int wr, int wc, int fr, int fq) const {
        int row0 = u.pm * 256 + wr * 64 + fr, col0 = u.pn * 256 + wc * 32 + 8 * fq;
        asm volatile("" : "+v"(row0), "+v"(col0));
#pragma unroll
        for (int ai = 0; ai < 2; ++ai)
#pragma unroll
            for (int m = 0; m < 4; ++m) { const size_t row = (size_t)(row0 + ai * 128 + m * 16); const bf16_t* gp = proj + row * NP + GATE0 + 3 * DM + col0;
#pragma unroll
                for (int bj = 0; bj < 2; ++bj) { float g8[8], o8[8]; ld8(gp + bj * 128, g8);
#pragma unroll
                    for (int e = 0; e < 4; ++e) { o8[e] = acc[ai][bj][m][0][e] * g8[e]; o8[4 + e] = acc[ai][bj][m][1][e] * g8[4 + e]; }
                    st8(O + row * DM + col0 + bj * 128, o8); }
                asm volatile("" ::: "memory"); }
    }
};
struct EpiOut {
    static constexpr bool RESCALE = false, PERM = true;
    const float* xin; float* out;
    __device__ __forceinline__ void operator()(AccT& acc, const Unit& u, int wr, int wc, int fr, int fq) const {
        int row0 = u.pm * 256 + wr * 64 + fr, col0 = u.pn * 256 + wc * 32 + 8 * fq;
        asm volatile("" : "+v"(row0), "+v"(col0));
#pragma unroll
        for (int ai = 0; ai < 2; ++ai)
#pragma unroll
            for (int m = 0; m < 4; ++m) { const size_t off = (size_t)(row0 + ai * 128 + m * 16) * DM + col0;
#pragma unroll
                for (int bj = 0; bj < 2; ++bj) { const f32x4 x0 = *(const f32x4*)(xin + off + bj * 128), x1 = *(const f32x4*)(xin + off + bj * 128 + 4);
                    *(f32x4*)(out + off + bj * 128) = x0 + acc[ai][bj][m][0]; *(f32x4*)(out + off + bj * 128 + 4) = x1 + acc[ai][bj][m][1]; } }
    }
};

__device__ __forceinline__ void tr_item(const float* W, int K, int N, bf16_t* WT, int ldk, int split, int shift, LAS float* scr, int item, int lane) {
    const int nblk = (N + 63) >> 6, kb = item / nblk, nb = item - kb * nblk, k0 = 64 * kb, n0 = 64 * nb;
    const int c4 = (lane & 15) * 4, rq = lane >> 4;
    const bool okc = n0 + c4 < N;
    f32x4 tv[16];
#pragma unroll
    for (int i = 0; i < 16; ++i) { const int kk = i * 4 + rq; tv[i] = okc ? *(const f32x4*)(W + (size_t)(k0 + kk) * N + n0 + c4) : (f32x4){0.f, 0.f, 0.f, 0.f}; }
#pragma unroll
    for (int i = 0; i < 16; ++i) { const int kk = i * 4 + rq; LAS float* d = scr + kk * 65 + c4; d[0] = tv[i][0]; d[1] = tv[i][1]; d[2] = tv[i][2]; d[3] = tv[i][3]; }
    LDS_FENCE();
    const int c = lane & 7;
#pragma unroll
    for (int j = 0; j < 8; ++j) { const int n = (lane >> 3) + 8 * j, ng = n0 + n;
        if (ng < N) { const LAS float* sp = scr + (8 * c) * 65 + n;
            u32x4 o; o.x = cvt_pk_bf16(sp[0], sp[65]); o.y = cvt_pk_bf16(sp[130], sp[195]); o.z = cvt_pk_bf16(sp[260], sp[325]); o.w = cvt_pk_bf16(sp[390], sp[455]);
            const int dr = ng < split ? ng : ng + shift;
            *(u32x4*)(WT + (size_t)dr * ldk + k0 + 8 * c) = o; } }
    LDS_FENCE();
}
__device__ __forceinline__ void tr_matrix(const float* W, int K, int N, bf16_t* WT, int ldk, int split, int shift, LAS float* scr, int gw, int ngw, int lane) {
    const int nitems = (K >> 6) * ((N + 63) >> 6);
    for (int it = gw; it < nitems; it += ngw) tr_item(W, K, N, WT, ldk, split, shift, scr, it, lane);
}
__device__ __forceinline__ void phase_weights(KP P, LAS unsigned char* lds) {
    const int tid = fresh_tid(), wave = tid >> 6, lane = tid & 63;
    const int gw = blockIdx.x * 8 + wave, ngw = gridDim.x * 8;
    LAS float* scr = (LAS float*)(lds + wave * 16896);
    for (int l = 0; l < DEPTH; ++l) {
        tr_matrix(P->in[3] + (size_t)l * DM * NIN, DM, NIN, (bf16_t*)(P->ws + W_WIN + l * SZ_WIN), DM, NG0, GATE0 - NG0, scr, gw, ngw, lane);
        tr_matrix(P->in[26] + (size_t)l * DM * DM, DM, DM, (bf16_t*)(P->ws + W_WUP + l * SZ_WSQ), DM, 1 << 30, 0, scr, gw, ngw, lane);
        tr_matrix(P->in[28] + (size_t)l * DM * DM, DM, DM, (bf16_t*)(P->ws + W_WOUT + l * SZ_WSQ), DM, 1 << 30, 0, scr, gw, ngw, lane);
        tr_matrix(P->in[8] + (size_t)l * 448 * 768, 448, 768, (bf16_t*)(P->ws + W_WUQ + l * SZ_WUQ), 512, 1 << 30, 0, scr, gw, ngw, lane);
        tr_matrix(P->in[9] + (size_t)l * 128 * 1024, 128, 1024, (bf16_t*)(P->ws + W_WUKV + l * SZ_WUKV), 256, 1 << 30, 0, scr, gw, ngw, lane);
        tr_matrix(P->in[24] + (size_t)l * 512 * 512, 512, 512, (bf16_t*)(P->ws + W_WGLU + l * SZ_WGLU), 512, 1 << 30, 0, scr, gw, ngw, lane);
    }
    const int gt = blockIdx.x * 512 + tid, ngt = gridDim.x * 512;
    const u32x4 z = {0u, 0u, 0u, 0u};
    for (int l = 0; l < DEPTH; ++l) {
        bf16_t* w = (bf16_t*)(P->ws + W_WIN + l * SZ_WIN) + (size_t)NG0 * DM;
        for (int i = gt; i < (GATE0 - NG0) * DM / 8; i += ngt) *(u32x4*)(w + (size_t)i * 8) = z;
        bf16_t* q = (bf16_t*)(P->ws + W_WUQ + l * SZ_WUQ);
        for (int i = gt; i < 768 * 8; i += ngt) *(u32x4*)(q + (size_t)(i >> 3) * 512 + 448 + (i & 7) * 8) = z;
        bf16_t* kv = (bf16_t*)(P->ws + W_WUKV + l * SZ_WUKV);
        for (int i = gt; i < 1024 * 16; i += ngt) *(u32x4*)(kv + (size_t)(i >> 4) * 256 + 128 + (i & 15) * 8) = z;
    }
}

__device__ __forceinline__ void phase_norm(const float* x, const float* g, bf16_t* h) {
    const int tid = fresh_tid(), wave = tid >> 6, lane = tid & 63;
    for (int row = blockIdx.x * 8 + wave; row < SEQ; row += gridDim.x * 8) {
        const f32x4* xr = (const f32x4*)(x + (size_t)row * DM) + lane;
        f32x4 v[8]; float ss = 0.f;
#pragma unroll
        for (int j = 0; j < 8; ++j) { v[j] = xr[64 * j]; ss += v[j][0] * v[j][0] + v[j][1] * v[j][1] + v[j][2] * v[j][2] + v[j][3] * v[j][3]; }
        const float rstd = rsqrtf(wave_sum(ss) * (1.f / DM) + EPS);
        u32x2* o = (u32x2*)(h + (size_t)row * DM) + lane;
#pragma unroll
        for (int j = 0; j < 8; ++j) { const f32x4 gg = *((const f32x4*)g + lane + 64 * j);
            u32x2 w; w.x = cvt_pk_bf16(v[j][0] * rstd * gg[0], v[j][1] * rstd * gg[1]); w.y = cvt_pk_bf16(v[j][2] * rstd * gg[2], v[j][3] * rstd * gg[3]); o[64 * j] = w; }
    }
}

__device__ __forceinline__ void a_prep_item(KP P, int l, int item, int lane, LAS unsigned char* ldsw) {
    const bf16_t* proj = (const bf16_t*)(P->ws + W_PROJ);
    const int hh = item >> 7, tile = item & 127, g = hh >> 2, dsh = 2 * g, L = SEQ >> dsh;
    const int tq = lane >> 4, ch = lane & 15;
    float gq[8], gk[8];
#pragma unroll
    for (int e = 0; e < 8; ++e) { gq[e] = P->in[4][l * 128 + ch * 8 + e] * (0.08838834764831845f * 1.4426950408889634f); gk[e] = P->in[5][l * 128 + ch * 8 + e]; }
    bf16_t* qd = (bf16_t*)(P->ws + W_QA) + ((size_t)hh * SEQ + tile * 64) * 128 + ch * 8;
    bf16_t* kd = (bf16_t*)(P->ws + W_KA) + ((size_t)hh * SEQ + tile * 64) * 128 + ch * 8;
#pragma unroll 4
    for (int i = 0; i < 16; ++i) {
        const int tok = i * 4 + tq, sp = tile * 64 + tok, r = sp / L, m = sp - r * L, sidx = (m << dsh) + r;
        const bf16_t* src = proj + (size_t)sidx * NP + hh * 128 + ch * 8;
        float a[8], b[8]; ld8(src + O_AQ, a); ld8(src + O_AK, b);
        const u32x4 vv = *(const u32x4*)(src + O_AV);
        float ssq = 0.f, ssk = 0.f;
#pragma unroll
        for (int e = 0; e < 8; ++e) { ssq += a[e] * a[e]; ssk += b[e] * b[e]; }
        ssq += __shfl_xor(ssq, 1); ssk += __shfl_xor(ssk, 1); ssq += __shfl_xor(ssq, 2); ssk += __shfl_xor(ssk, 2);
        ssq += __shfl_xor(ssq, 4); ssk += __shfl_xor(ssk, 4); ssq += __shfl_xor(ssq, 8); ssk += __shfl_xor(ssk, 8);
        const float rq = rsqrtf(ssq * (1.f / 128) + EPS), rk = rsqrtf(ssk * (1.f / 128) + EPS);
#pragma unroll
        for (int e = 0; e < 8; ++e) { a[e] *= rq * gq[e]; b[e] *= rk * gk[e]; }
        st8(qd + (size_t)tok * 128, a); st8(kd + (size_t)tok * 128, b);
        *(LAS u32x4*)(ldsw + tok * 256 + ((ch ^ (tok >> 3)) << 4)) = vv;
    }
    LDS_FENCE();
    bf16_t* vd = (bf16_t*)(P->ws + W_VAT) + (size_t)hh * 128 * SEQ + tile * 64;
    const int c8 = lane & 7;
#pragma unroll 2
    for (int j = 0; j < 16; ++j) { const int dv = j * 8 + (lane >> 3);
        const LAS bf16_t* tp = (const LAS bf16_t*)ldsw + (c8 * 8) * 128 + (dv ^ (c8 << 3));
        u32x4 o; o.x = (unsigned)tp[0] | ((unsigned)tp[128] << 16); o.y = (unsigned)tp[256] | ((unsigned)tp[384] << 16);
        o.z = (unsigned)tp[512] | ((unsigned)tp[640] << 16); o.w = (unsigned)tp[768] | ((unsigned)tp[896] << 16);
        *(u32x4*)(vd + (size_t)dv * SEQ + c8 * 8) = o; }
    LDS_FENCE();
}
__device__ __forceinline__ void b_prep1_cq(KP P, int l, int s_, int lane) {
    const bf16_t* proj = (const bf16_t*)(P->ws + W_PROJ);
    float a[8];
#pragma unroll
    for (int e = 0; e < 8; ++e) a[e] = 0.f;
    if (lane < 56) ld8(proj + (size_t)s_ * NP + O_BCQ + lane * 8, a);
    float ss = 0.f;
#pragma unroll
    for (int e = 0; e < 8; ++e) ss += a[e] * a[e];
    const float rs = rsqrtf(wave_sum(ss) * (1.f / 448) + EPS);
    if (lane < 56) {
#pragma unroll
        for (int e = 0; e < 8; ++e) a[e] *= rs * P->in[6][l * 448 + lane * 8 + e]; }
    st8((bf16_t*)(P->ws + W_CQN) + (size_t)s_ * 512 + lane * 8, a);
}
__device__ __forceinline__ void b_prep1_ckv(KP P, int l, int item, int lane) {
    const bf16_t* proj = (const bf16_t*)(P->ws + W_PROJ);
    const int s_ = item * 4 + (lane >> 4), ch = lane & 15;
    float a[8]; ld8(proj + (size_t)s_ * NP + O_BCKV + ch * 8, a);
    float ss = 0.f;
#pragma unroll
    for (int e = 0; e < 8; ++e) ss += a[e] * a[e];
    ss += __shfl_xor(ss, 1); ss += __shfl_xor(ss, 2); ss += __shfl_xor(ss, 4); ss += __shfl_xor(ss, 8);
    const float rs = rsqrtf(ss * (1.f / 128) + EPS);
#pragma unroll
    for (int e = 0; e < 8; ++e) a[e] *= rs * P->in[7][l * 128 + ch * 8 + e];
    bf16_t* dst = (bf16_t*)(P->ws + W_CKVN) + (size_t)s_ * 256 + ch * 8;
    st8(dst, a);
    unsigned zz = 0u; asm volatile("" : "+v"(zz)); const u32x4 z = {zz, zz, zz, zz}; *(u32x4*)(dst + 128) = z;
}

__device__ __forceinline__ float log_sigmoidf_(float x) { return fminf(x, 0.f) - __logf(1.f + __expf(-fabsf(x))); }
__device__ __forceinline__ void conv8(const bf16_t* proj, const float* cw, const float* cb, int ts, int ch, float sc, float (&o)[8]) {
    float acc[8];
#pragma unroll
    for (int e = 0; e < 8; ++e) acc[e] = cb[ch + e];
#pragma unroll
    for (int j = 0; j < 4; ++j) { const int t = ts - 3 + j;
        if (t >= 0) { float a[8]; ld8(proj + (size_t)t * NP + O_CQK + ch, a);
#pragma unroll
            for (int e = 0; e < 8; ++e) acc[e] += a[e] * cw[j * 512 + ch + e]; } }
#pragma unroll
    for (int e = 0; e < 8; ++e) o[e] = siluf_(acc[e]) * sc;
}
__device__ __forceinline__ void c1_item(KP P, int l, int item, LAS unsigned char* lds) {
    const bf16_t* proj = (const bf16_t*)(P->ws + W_PROJ);
    const int tid = fresh_tid(), lane = tid & 63, wave = tid >> 6, c = item >> 2, h = item & 3, t0 = c * 64, fr = lane & 15, fq = lane >> 4;
    LAS float* wl = (LAS float*)lds;
    LAS bf16_t* VT = (LAS bf16_t*)(lds + 256);
    LAS bf16_t* KWT = VT + 128 * 72;
    const float* cw = P->in[12] + l * 2048; const float* cb = P->in[13] + l * 512;
    if (tid < 64) {
        const bf16_t* row = proj + (size_t)(t0 + lane) * NP;
        const float lf = log_sigmoidf_(bf2f(row[O_CF + h]) + P->in[15][l * 4 + h]);
        const float ig = bf2f(row[O_CI + h]) + P->in[14][l * 4 + h];
        float b = lf;
#pragma unroll
        for (int o = 1; o < 64; o <<= 1) { const float t = __shfl_up(b, o); if (lane >= o) b += t; }
        const float bL = __shfl(b, 63);
        const float gs = bL - b + ig;
        const float mloc = wave_max(gs);
        wl[lane] = __expf(gs - mloc);
        if (lane == 0) { float* meta = (float*)(P->ws + W_META) + item * 2; meta[0] = bL; meta[1] = mloc; }
    }
    __syncthreads();
    { const int s_ = tid >> 3, dg = tid & 7; float k8[8]; conv8(proj, cw, cb, t0 + s_, 256 + h * 64 + dg * 8, 0.125f, k8);
      const float w = wl[s_];
#pragma unroll
      for (int e = 0; e < 8; ++e) KWT[(dg * 8 + e) * 72 + s_] = f2bf(k8[e] * w); }
#pragma unroll
    for (int i = 0; i < 2; ++i) { const int id = tid + i * 512, s_ = id >> 4, cg8 = id & 15;
        const u32x4 vv = *(const u32x4*)(proj + (size_t)(t0 + s_) * NP + O_CV + h * 128 + cg8 * 8);
        LAS bf16_t* vp = VT + (cg8 * 8) * 72 + s_;
        vp[0] = (bf16_t)(vv.x & 0xffffu); vp[72] = (bf16_t)(vv.x >> 16); vp[144] = (bf16_t)(vv.y & 0xffffu); vp[216] = (bf16_t)(vv.y >> 16);
        vp[288] = (bf16_t)(vv.z & 0xffffu); vp[360] = (bf16_t)(vv.z >> 16); vp[432] = (bf16_t)(vv.w & 0xffffu); vp[504] = (bf16_t)(vv.w >> 16); }
    __syncthreads();
    { const int dsub = wave & 3;
#pragma unroll
      for (int vv = 0; vv < 4; ++vv) { const int vs = (wave >> 2) * 4 + vv; f32x4 acc = {0.f, 0.f, 0.f, 0.f};
#pragma unroll
          for (int ks = 0; ks < 2; ++ks) { const bf16x8 a = *(const LAS bf16x8*)(KWT + (dsub * 16 + fr) * 72 + ks * 32 + fq * 8), b = *(const LAS bf16x8*)(VT + (vs * 16 + fr) * 72 + ks * 32 + fq * 8);
              acc = __builtin_amdgcn_mfma_f32_16x16x32_bf16(a, b, acc, 0, 0, 0); }
          *(f32x4*)((float*)(P->ws + W_CLOC) + ((size_t)item * 128 + vs * 16 + fr) * 64 + dsub * 16 + fq * 4) = acc; } }
    if (tid < 64) { float nl = 0.f; for (int s_ = 0; s_ < 64; ++s_) nl += bf2f(KWT[tid * 72 + s_]); ((float*)(P->ws + W_NLOC))[item * 64 + tid] = nl; }
    __syncthreads();
}
__device__ __forceinline__ void c2_multi(KP P, int e0, int estride, const LAS float* metaL) {
    const float* locp[3]; float* stp[3]; int hh[3]; bool isn[3], ok[3]; size_t strd[3];
    float* mst = (float*)(P->ws + W_MST);
#pragma unroll
    for (int k = 0; k < 3; ++k) { const int e = e0 + k * estride; ok[k] = e < 33024; const int ec = ok[k] ? e : 0;
        isn[k] = ec >= 32768; const int ee = isn[k] ? ec - 32768 : ec;
        hh[k] = isn[k] ? ee >> 6 : ee >> 13; const int idx = isn[k] ? ee & 63 : ee & 8191; strd[k] = isn[k] ? 64 : 8192;
        locp[k] = (isn[k] ? (const float*)(P->ws + W_NLOC) : (const float*)(P->ws + W_CLOC)) + idx;
        stp[k] = (isn[k] ? (float*)(P->ws + W_NST) : (float*)(P->ws + W_CST)) + idx;
        isn[k] = isn[k] && idx == 0 && ok[k]; }
    float m[3] = {0.f, 0.f, 0.f}, val[3] = {0.f, 0.f, 0.f};
#pragma unroll 1
    for (int c0 = 0; c0 < 128; c0 += 16) {
        float lv[3][16];
#pragma unroll
        for (int k = 0; k < 3; ++k)
#pragma unroll
            for (int i = 0; i < 16; ++i) lv[k][i] = ok[k] ? locp[k][(size_t)((c0 + i) * 4 + hh[k]) * strd[k]] : 0.f;
#pragma unroll
        for (int i = 0; i < 16; ++i)
#pragma unroll
            for (int k = 0; k < 3; ++k) { const int it = (c0 + i) * 4 + hh[k]; const float bl = metaL[it * 2], ml = metaL[it * 2 + 1];
                if (ok[k]) stp[k][(size_t)it * strd[k]] = val[k];
                if (isn[k]) mst[it] = m[k];
                const float mn = fmaxf(bl + m[k], ml);
                val[k] = __expf(bl + m[k] - mn) * val[k] + __expf(ml - mn) * lv[k][i]; m[k] = mn; }
    }
}
__device__ __forceinline__ void c3_item(KP P, int l, int item, LAS unsigned char* lds) {
    const bf16_t* proj = (const bf16_t*)(P->ws + W_PROJ);
    const int tid = fresh_tid(), lane = tid & 63, wave = tid >> 6, c = item >> 2, h = item & 3, t0 = c * 64, fr = lane & 15, fq = lane >> 4;
    LAS float* bb = (LAS float*)lds;
    LAS float* gi = bb + 64;
    LAS float* mtl = gi + 64;
    LAS float* wil = mtl + 64;
    LAS float* nnl = wil + 64;
    LAS float* nql = nnl + 64;
    LAS float* rsl = nql + 64;
    LAS bf16_t* Qs = (LAS bf16_t*)(lds + 2048);
    LAS bf16_t* Ks = Qs + 64 * 72;
    LAS bf16_t* SQ = Ks + 64 * 72;
    LAS bf16_t* VT = SQ + 64 * 72;
    LAS bf16_t* Cs = VT + 128 * 72;
    const float* cw = P->in[12] + l * 2048; const float* cb = P->in[13] + l * 512;
    const float m_in = ((const float*)(P->ws + W_MST))[item];
    if (tid < 64) {
        const bf16_t* row = proj + (size_t)(t0 + lane) * NP;
        const float lf = log_sigmoidf_(bf2f(row[O_CF + h]) + P->in[15][l * 4 + h]);
        const float ig = bf2f(row[O_CI + h]) + P->in[14][l * 4 + h];
        float b = lf;
#pragma unroll
        for (int o = 1; o < 64; o <<= 1) { const float t = __shfl_up(b, o); if (lane >= o) b += t; }
        const float d = ig - b; float pm = d;
#pragma unroll
        for (int o = 1; o < 64; o <<= 1) { const float t = __shfl_up(pm, o); if (lane >= o) pm = fmaxf(pm, t); }
        const float mt = b + fmaxf(m_in, pm);
        bb[lane] = b; gi[lane] = d; mtl[lane] = mt; wil[lane] = __expf(b + m_in - mt);
        nnl[lane] = ((const float*)(P->ws + W_NST))[item * 64 + lane];
    }
    { const int s_ = tid >> 3, dg = tid & 7; float a[8]; u32x4 w;
      conv8(proj, cw, cb, t0 + s_, h * 64 + dg * 8, 1.f, a);
      w.x = cvt_pk_bf16(a[0], a[1]); w.y = cvt_pk_bf16(a[2], a[3]); w.z = cvt_pk_bf16(a[4], a[5]); w.w = cvt_pk_bf16(a[6], a[7]);
      *(LAS u32x4*)(Qs + s_ * 72 + dg * 8) = w;
      conv8(proj, cw, cb, t0 + s_, 256 + h * 64 + dg * 8, 0.125f, a);
      w.x = cvt_pk_bf16(a[0], a[1]); w.y = cvt_pk_bf16(a[2], a[3]); w.z = cvt_pk_bf16(a[4], a[5]); w.w = cvt_pk_bf16(a[6], a[7]);
      *(LAS u32x4*)(Ks + s_ * 72 + dg * 8) = w; }
#pragma unroll
    for (int i = 0; i < 2; ++i) { const int id = tid + i * 512, s_ = id >> 4, cg8 = id & 15;
        const u32x4 vv = *(const u32x4*)(proj + (size_t)(t0 + s_) * NP + O_CV + h * 128 + cg8 * 8);
        LAS bf16_t* vp = VT + (cg8 * 8) * 72 + s_;
        vp[0] = (bf16_t)(vv.x & 0xffffu); vp[72] = (bf16_t)(vv.x >> 16); vp[144] = (bf16_t)(vv.y & 0xffffu); vp[216] = (bf16_t)(vv.y >> 16);
        vp[288] = (bf16_t)(vv.z & 0xffffu); vp[360] = (bf16_t)(vv.z >> 16); vp[432] = (bf16_t)(vv.w & 0xffffu); vp[504] = (bf16_t)(vv.w >> 16); }
    { const float* cst = (const float*)(P->ws + W_CST) + (size_t)item * 8192;
#pragma unroll
      for (int i = 0; i < 4; ++i) { const int id = tid + i * 512, v = id >> 4, d4 = (id & 15) * 4; const f32x4 x = *(const f32x4*)(cst + v * 64 + d4);
          u32x2 w; w.x = cvt_pk_bf16(x[0], x[1]); w.y = cvt_pk_bf16(x[2], x[3]); *(LAS u32x2*)(Cs + v * 72 + d4) = w; } }
    __syncthreads();
    { const int tsub = wave >> 1; float rsum[4] = {0.f, 0.f, 0.f, 0.f};
#pragma unroll
      for (int q2 = 0; q2 < 2; ++q2) { const int ssub = (wave & 1) * 2 + q2; f32x4 acc = {0.f, 0.f, 0.f, 0.f};
#pragma unroll
          for (int ks = 0; ks < 2; ++ks) { const bf16x8 a = *(const LAS bf16x8*)(Qs + (tsub * 16 + fr) * 72 + ks * 32 + fq * 8), b = *(const LAS bf16x8*)(Ks + (ssub * 16 + fr) * 72 + ks * 32 + fq * 8);
              acc = __builtin_amdgcn_mfma_f32_16x16x32_bf16(a, b, acc, 0, 0, 0); }
          const int ss = ssub * 16 + fr; const float gs = gi[ss];
#pragma unroll
          for (int j = 0; j < 4; ++j) { const int tt = tsub * 16 + fq * 4 + j;
              const float val = (ss <= tt) ? __expf(bb[tt] + gs - mtl[tt]) * acc[j] : 0.f;
              SQ[tt * 72 + ss] = f2bf(val); rsum[j] += val; } }
#pragma unroll
      for (int j = 0; j < 4; ++j) { const float r = row16_sum(rsum[j]); if (fr == 0) rsl[(tsub * 16 + fq * 4 + j) * 2 + (wave & 1)] = r; } }
    { const int t = tid >> 3, part = tid & 7; float a[8]; const u32x4 u = *(const LAS u32x4*)(Qs + t * 72 + part * 8);
      a[0] = bflo(u.x); a[1] = bfhi(u.x); a[2] = bflo(u.y); a[3] = bfhi(u.y); a[4] = bflo(u.z); a[5] = bfhi(u.z); a[6] = bflo(u.w); a[7] = bfhi(u.w);
      float p = 0.f;
#pragma unroll
      for (int e = 0; e < 8; ++e) p += a[e] * nnl[part * 8 + e];
      p += __shfl_xor(p, 1); p += __shfl_xor(p, 2); p += __shfl_xor(p, 4);
      if (part == 0) nql[t] = p; }
    __syncthreads();
    { const int tsub = wave >> 1, t = tsub * 16 + fr;
      const float wi = wil[t], den = wi * nql[t] + rsl[t * 2] + rsl[t * 2 + 1];
      const float inv = 1.f / fmaxf(fabsf(den), __expf(-mtl[t]));
      bf16x8 qb[2], sb[2];
#pragma unroll
      for (int ks = 0; ks < 2; ++ks) { qb[ks] = *(const LAS bf16x8*)(Qs + t * 72 + ks * 32 + fq * 8); sb[ks] = *(const LAS bf16x8*)(SQ + t * 72 + ks * 32 + fq * 8); }
#pragma unroll
      for (int vv = 0; vv < 4; ++vv) { const int vs = (wave & 1) * 4 + vv; f32x4 inter = {0.f, 0.f, 0.f, 0.f}, intra = {0.f, 0.f, 0.f, 0.f};
#pragma unroll
          for (int ks = 0; ks < 2; ++ks) { const bf16x8 ca = *(const LAS bf16x8*)(Cs + (vs * 16 + fr) * 72 + ks * 32 + fq * 8), va = *(const LAS bf16x8*)(VT + (vs * 16 + fr) * 72 + ks * 32 + fq * 8);
              inter = __builtin_amdgcn_mfma_f32_16x16x32_bf16(ca, qb[ks], inter, 0, 0, 0);
              intra = __builtin_amdgcn_mfma_f32_16x16x32_bf16(va, sb[ks], intra, 0, 0, 0); }
          const int v0 = vs * 16 + fq * 4;
          const bf16_t* prow = proj + (size_t)(t0 + t) * NP + h * 128 + v0;
          const u32x2 op = *(const u32x2*)(prow + O_CO), zz = *(const u32x2*)(prow + O_CZ);
          const float o0 = sigmoidf_(bflo(op.x)) * (wi * inter[0] + intra[0]) * inv * siluf_(bflo(zz.x));
          const float o1 = sigmoidf_(bfhi(op.x)) * (wi * inter[1] + intra[1]) * inv * siluf_(bfhi(zz.x));
          const float o2 = sigmoidf_(bflo(op.y)) * (wi * inter[2] + intra[2]) * inv * siluf_(bflo(zz.y));
          const float o3 = sigmoidf_(bfhi(op.y)) * (wi * inter[3] + intra[3]) * inv * siluf_(bfhi(zz.y));
          u32x2 w; w.x = cvt_pk_bf16(o0, o1); w.y = cvt_pk_bf16(o2, o3);
          *(u32x2*)((bf16_t*)(P->ws + W_YS) + (size_t)(t0 + t) * DM + 1024 + h * 128 + v0) = w; } }
    __syncthreads();
}

struct S5Lane { float are, aim, bre[16], bim[16]; };
__device__ __forceinline__ void s5_setup(KP P, int l, int g, int p, S5Lane& L) {
    const int gp = (l * 32 + g) * 64 + p;
    const float lr = P->in[16][gp], li = P->in[17][gp], dt = expf(P->in[18][l * 32 + g]);
    const float mag = expf(lr * dt); float sn, cs; sincosf(li * dt, &sn, &cs);
    L.are = mag * cs; L.aim = mag * sn;
    const float den = lr * lr + li * li;
    const float fre = ((L.are - 1.f) * lr + L.aim * li) / den, fim = (L.aim * lr - (L.are - 1.f) * li) / den;
    const f32x4* br = (const f32x4*)(P->in[19] + (size_t)gp * 16); const f32x4* bi = (const f32x4*)(P->in[20] + (size_t)gp * 16);
#pragma unroll
    for (int j = 0; j < 4; ++j) { const f32x4 r = br[j], i = bi[j];
#pragma unroll
        for (int e = 0; e < 4; ++e) { L.bre[j * 4 + e] = fre * r[e] - fim * i[e]; L.bim[j * 4 + e] = fre * i[e] + fim * r[e]; } }
}
__device__ __forceinline__ void s5_step(const S5Lane& L, const bf16_t* urow, float& xr, float& xi) {
    float u0[8], u1[8]; ld8(urow, u0); ld8(urow + 8, u1);
    float br = 0.f, bi = 0.f;
#pragma unroll
    for (int e = 0; e < 8; ++e) { br += u0[e] * L.bre[e]; bi += u0[e] * L.bim[e]; }
#pragma unroll
    for (int e = 0; e < 8; ++e) { br += u1[e] * L.bre[8 + e]; bi += u1[e] * L.bim[8 + e]; }
    const float nr = L.are * xr - L.aim * xi + br, ni = L.are * xi + L.aim * xr + bi;
    xr = nr; xi = ni;
}
__device__ __forceinline__ float gelu_tanh(float x) {
    const float u = 0.7978845608028654f * (x + 0.044715f * x * x * x);
    const float e = __expf(2.f * u);
    const float th = 1.f - 2.f * __builtin_amdgcn_rcpf(e + 1.f);
    return 0.5f * x * (1.f + th);
}
__device__ __forceinline__ unsigned pack_bf2(float a, float b) { return cvt_pk_bf16(a, b); }
template <bool OUT>
__device__ __forceinline__ void s5_item(KP P, int l, int item, int lane, LAS unsigned char* ldsw) {
    const bf16_t* proj = (const bf16_t*)(P->ws + W_PROJ);
    const int c = item >> 5, g = item & 31, fr = lane & 15, fq = lane >> 4, lg = l * 32 + g;
    LAS float* buL = (LAS float*)ldsw;
    LAS bf16_t* xL = (LAS bf16_t*)(ldsw + 8448);
    const float dt = expf(P->in[18][lg]);
    float are, aim;
    { const float lr = P->in[16][lg * 64 + lane], li = P->in[17][lg * 64 + lane]; const float mag = expf(lr * dt); float sn, cs; sincosf(li * dt, &sn, &cs); are = mag * cs; aim = mag * sn; }
    bf16x8 bfr[8];
#pragma unroll
    for (int q = 0; q < 4; ++q) {
        u32x4 wr = {0u, 0u, 0u, 0u}, wi = {0u, 0u, 0u, 0u};
        if (fq < 2) {
            const int pp = q * 16 + fr, gp = lg * 64 + pp;
            const float lr = P->in[16][gp], li = P->in[17][gp]; const float mag = expf(lr * dt); float sn, cs; sincosf(li * dt, &sn, &cs);
            const float ar = mag * cs, ai = mag * sn, den = lr * lr + li * li;
            const float fre = ((ar - 1.f) * lr + ai * li) / den, fim = (ai * lr - (ar - 1.f) * li) / den;
            const f32x4 r0 = *(const f32x4*)(P->in[19] + (size_t)gp * 16 + fq * 8), r1 = *(const f32x4*)(P->in[19] + (size_t)gp * 16 + fq * 8 + 4);
            const f32x4 i0 = *(const f32x4*)(P->in[20] + (size_t)gp * 16 + fq * 8), i1 = *(const f32x4*)(P->in[20] + (size_t)gp * 16 + fq * 8 + 4);
            wr.x = pack_bf2(fre * r0[0] - fim * i0[0], fre * r0[1] - fim * i0[1]); wr.y = pack_bf2(fre * r0[2] - fim * i0[2], fre * r0[3] - fim * i0[3]);
            wr.z = pack_bf2(fre * r1[0] - fim * i1[0], fre * r1[1] - fim * i1[1]); wr.w = pack_bf2(fre * r1[2] - fim * i1[2], fre * r1[3] - fim * i1[3]);
            wi.x = pack_bf2(fre * i0[0] + fim * r0[0], fre * i0[1] + fim * r0[1]); wi.y = pack_bf2(fre * i0[2] + fim * r0[2], fre * i0[3] + fim * r0[3]);
            wi.z = pack_bf2(fre * i1[0] + fim * r1[0], fre * i1[1] + fim * r1[1]); wi.w = pack_bf2(fre * i1[2] + fim * r1[2], fre * i1[3] + fim * r1[3]);
        }
        bfr[q] = __builtin_bit_cast(bf16x8, wr); bfr[4 + q] = __builtin_bit_cast(bf16x8, wi);
    }
    bf16x8 cfr[4]; float dsk = 0.f;
    if (OUT) {
#pragma unroll
        for (int ks = 0; ks < 4; ++ks) { const float* src = (ks < 2 ? P->in[21] : P->in[22]) + ((size_t)lg * 16 + fr) * 64 + (ks & 1) * 32 + fq * 8; const float sg = ks < 2 ? 1.f : -1.f;
            const f32x4 a = *(const f32x4*)src, b = *(const f32x4*)(src + 4);
            u32x4 w; w.x = pack_bf2(sg * a[0], sg * a[1]); w.y = pack_bf2(sg * a[2], sg * a[3]); w.z = pack_bf2(sg * b[0], sg * b[1]); w.w = pack_bf2(sg * b[2], sg * b[3]);
            cfr[ks] = __builtin_bit_cast(bf16x8, w); }
        dsk = P->in[23][l * 512 + g * 16 + fr];
    }
    float xr = 0.f, xi = 0.f;
    if (OUT) { const float* xs = (const float*)(P->ws + W_XST) + ((size_t)c * 2048 + g * 64 + lane) * 2; xr = xs[0]; xi = xs[1]; }
#pragma unroll 1
    for (int sub = 0; sub < 4; ++sub) {
        const int tb = c * 64 + sub * 16;
        u32x4 uw = {0u, 0u, 0u, 0u};
        if (fq < 2) uw = *(const u32x4*)(proj + (size_t)(tb + fr) * NP + O_DU + g * 16 + fq * 8);
        const bf16x8 ua = __builtin_bit_cast(bf16x8, uw);
#pragma unroll
        for (int ns = 0; ns < 8; ++ns) { const f32x4 z = {0.f, 0.f, 0.f, 0.f}; const f32x4 r = __builtin_amdgcn_mfma_f32_16x16x32_bf16(ua, bfr[ns], z, 0, 0, 0);
#pragma unroll
            for (int j = 0; j < 4; ++j) buL[(fq * 4 + j) * 132 + ns * 16 + fr] = r[j]; }
        LDS_FENCE();
#pragma unroll
        for (int t = 0; t < 16; ++t) { const float br = buL[t * 132 + lane], bi = buL[t * 132 + 64 + lane];
            const float nr = are * xr - aim * xi + br, ni = are * xi + aim * xr + bi; xr = nr; xi = ni;
            if (OUT) { xL[t * 136 + lane] = f2bf(xr); xL[t * 136 + 64 + lane] = f2bf(xi); } }
        if (OUT) {
            LDS_FENCE();
            f32x4 y = {0.f, 0.f, 0.f, 0.f};
#pragma unroll
            for (int ks = 0; ks < 4; ++ks) { const bf16x8 af = *(const LAS bf16x8*)(xL + fr * 136 + ks * 32 + fq * 8); y = __builtin_amdgcn_mfma_f32_16x16x32_bf16(af, cfr[ks], y, 0, 0, 0); }
#pragma unroll
            for (int j = 0; j < 4; ++j) { const size_t trow = (size_t)(tb + fq * 4 + j);
                const float uu = bf2f(proj[trow * NP + O_DU + g * 16 + fr]);
                ((bf16_t*)(P->ws + W_YD))[trow * 512 + g * 16 + fr] = f2bf(gelu_tanh(y[j] + dsk * uu)); }
        }
        LDS_FENCE();
    }
    if (!OUT) { float* xe = (float*)(P->ws + W_XEND) + ((size_t)c * 2048 + g * 64 + lane) * 2; xe[0] = xr; xe[1] = xi; }
}
__device__ __forceinline__ void d2_elem(KP P, int l, int e) {
    const int gp = l * 2048 + e;
    const float lr = P->in[16][gp], li = P->in[17][gp], dt = expf(P->in[18][l * 32 + (e >> 6)]);
    const float mag = expf(lr * dt); float sn, cs; sincosf(li * dt, &sn, &cs);
    float ar = mag * cs, ai = mag * sn;
#pragma unroll
    for (int i = 0; i < 6; ++i) { const float r = ar * ar - ai * ai, im = 2.f * ar * ai; ar = r; ai = im; }
    const float* xe = (const float*)(P->ws + W_XEND); float* xs = (float*)(P->ws + W_XST);
    float xr = 0.f, xi = 0.f;
#pragma unroll 1
    for (int c0 = 0; c0 < 128; c0 += 32) {
        float er[32], ei[32];
#pragma unroll
        for (int i = 0; i < 32; ++i) { const size_t o = ((size_t)(c0 + i) * 2048 + e) * 2; er[i] = xe[o]; ei[i] = xe[o + 1]; }
#pragma unroll
        for (int i = 0; i < 32; ++i) { const size_t o = ((size_t)(c0 + i) * 2048 + e) * 2; xs[o] = xr; xs[o + 1] = xi;
            const float nr = ar * xr - ai * xi + er[i], ni = ar * xi + ai * xr + ei[i]; xr = nr; xi = ni; }
    }
}
__device__ __forceinline__ void b_prep2_item(KP P, int l, int s_, int lane) {
    const bf16_t* proj = (const bf16_t*)(P->ws + W_PROJ);
    const int h = lane >> 4, i = lane & 15;
    const bool hasr = i < 8, isx1 = i < 4;
    const float posf = (float)((const int*)P->in[1])[s_];
    float cs[8], sn[8];
#pragma unroll
    for (int e = 0; e < 8; ++e) { const int fi = (i & 3) * 8 + e;
        const float inv = exp2f(-(float)fi * 0.41524101186092029f);
        const float ang = posf * inv;
        const double t = (double)ang * 0.15915494309189535;
        const float fr = (float)(t - __builtin_rint(t));
        sn[e] = __builtin_amdgcn_sinf(fr); cs[e] = __builtin_amdgcn_cosf(fr); }
    const bf16_t* qsrc = (const bf16_t*)(P->ws + W_QRAW) + (size_t)s_ * 768 + h * 192;
    const bf16_t* ksrc = (const bf16_t*)(P->ws + W_KVRAW) + (size_t)s_ * 1024 + h * 256;
    const bf16_t* krsrc = proj + (size_t)s_ * NP + O_BKR;
    bf16_t* qd = (bf16_t*)(P->ws + W_QB) + ((size_t)h * SEQ + s_) * 192;
    bf16_t* kd = (bf16_t*)(P->ws + W_KB) + ((size_t)h * SEQ + s_) * 192;
#pragma unroll
    for (int w = 0; w < 2; ++w) {
        float a[8], ar[8];
#pragma unroll
        for (int e = 0; e < 8; ++e) ar[e] = 0.f;
        ld8((w ? ksrc : qsrc) + i * 8, a);
        if (hasr) ld8(w ? krsrc + i * 8 : qsrc + 128 + i * 8, ar);
        float ss = 0.f;
#pragma unroll
        for (int e = 0; e < 8; ++e) ss += a[e] * a[e] + ar[e] * ar[e];
        ss += __shfl_xor(ss, 1); ss += __shfl_xor(ss, 2); ss += __shfl_xor(ss, 4); ss += __shfl_xor(ss, 8);
        const float rs = rsqrtf(ss * (1.f / 192) + EPS) * (w ? 1.f : 0.07216878364870322f * 1.4426950408889634f);
        const float* gg = (w ? P->in[11] : P->in[10]) + l * 192;
        float o[8];
#pragma unroll
        for (int e = 0; e < 8; ++e) { a[e] *= rs * gg[i * 8 + e]; ar[e] *= rs * gg[128 + (i & 7) * 8 + e]; }
#pragma unroll
        for (int e = 0; e < 8; ++e) { const float pr = __shfl_xor(ar[e], 4);
            o[e] = isx1 ? ar[e] * cs[e] - pr * sn[e] : ar[e] * cs[e] + pr * sn[e]; }
        bf16_t* dd = w ? kd : qd;
        st8(dd + i * 8, a);
        if (hasr) st8(dd + 128 + i * 8, o);
    }
}

template <int DQK>
__device__ __forceinline__ void attn_block(LAS unsigned char* lds, const bf16_t* Qp, const bf16_t* Kp, const bf16_t* VTp, int q_idx0, int kt_lo, int kt_hi,
                                           int maxdelta, float bslope, int dsh, bf16_t* Op, float* Lp, int head) {
    constexpr int KS = DQK + 8, KC = DQK / 8, NKC = 64 * KC / 512, KBYTES = 64 * KS * 2, VBYTES = 128 * 72 * 2;
    const int tid = fresh_tid(), wave = tid >> 6, lane = tid & 63, fr = lane & 15, fq = lane >> 4;
    LAS unsigned char* Kb = lds; LAS unsigned char* Vb = lds + 2 * KBYTES; LAS unsigned char* Pw = lds + 2 * KBYTES + 2 * VBYTES + wave * (16 * 72 * 2);
    bf16x8 qf[DQK / 32];
#pragma unroll
    for (int ks = 0; ks < DQK / 32; ++ks) qf[ks] = *(const bf16x8*)(Qp + (size_t)(wave * 16 + fr) * DQK + ks * 32 + fq * 8);
    f32x4 o[8]; float m_run[4], l_run[4];
#pragma unroll
    for (int i = 0; i < 8; ++i) o[i] = (f32x4){0.f, 0.f, 0.f, 0.f};
#pragma unroll
    for (int j = 0; j < 4; ++j) { m_run[j] = -1e30f; l_run[j] = 0.f; }
    u32x4 kreg[NKC], vreg[2];
#define ATT_LOAD(kt) do { _Pragma("unroll") for (int _i = 0; _i < NKC; ++_i) { const int id = tid + _i * 512, row = id / KC, c8 = id - row * KC; kreg[_i] = *(const u32x4*)(Kp + (size_t)((kt) * 64 + row) * DQK + c8 * 8); } \
        _Pragma("unroll") for (int _i = 0; _i < 2; ++_i) { const int id = tid + _i * 512, row = id >> 3, c8 = id & 7; vreg[_i] = *(const u32x4*)(VTp + (size_t)row * SEQ + (kt) * 64 + c8 * 8); } } while (0)
#define ATT_STORE(buf) do { _Pragma("unroll") for (int _i = 0; _i < NKC; ++_i) { const int id = tid + _i * 512, row = id / KC, c8 = id - row * KC; *(LAS u32x4*)(Kb + (buf) * KBYTES + (row * KS + c8 * 8) * 2) = kreg[_i]; } \
        _Pragma("unroll") for (int _i = 0; _i < 2; ++_i) { const int id = tid + _i * 512, row = id >> 3, c8 = id & 7; *(LAS u32x4*)(Vb + (buf) * VBYTES + (row * 72 + c8 * 8) * 2) = vreg[_i]; } } while (0)
    if (kt_lo < kt_hi) { ATT_LOAD(kt_lo); ATT_STORE(0); }
    __syncthreads();
#pragma unroll
    for (int ks = 0; ks < DQK / 32; ++ks) asm volatile("" : "+v"(qf[ks]));
    auto tile_step = [&](auto masktag, int kt) {
        const int cur = (kt - kt_lo) & 1;
        if (kt + 1 < kt_hi) ATT_LOAD(kt + 1);
        f32x4 s[4];
#pragma unroll
        for (int n = 0; n < 4; ++n) s[n] = (f32x4){0.f, 0.f, 0.f, 0.f};
        { bf16x8 kf[2][4];
          const LAS unsigned char* kbase_p = Kb + cur * KBYTES + (fr * KS + fq * 8) * 2;
#pragma unroll
          for (int n = 0; n < 4; ++n) kf[0][n] = *(const LAS bf16x8*)(kbase_p + (n * 16 * KS) * 2);
#pragma unroll
          for (int ks = 0; ks < DQK / 32; ++ks) {
              if (ks + 1 < DQK / 32) {
#pragma unroll
                  for (int n = 0; n < 4; ++n) kf[(ks + 1) & 1][n] = *(const LAS bf16x8*)(kbase_p + (n * 16 * KS + (ks + 1) * 32) * 2); }
              __builtin_amdgcn_sched_barrier(0);
#pragma unroll
              for (int n = 0; n < 4; ++n) s[n] = __builtin_amdgcn_mfma_f32_16x16x32_bf16(qf[ks], kf[ks & 1][n], s[n], 0, 0, 0);
              __builtin_amdgcn_sched_barrier(0);
          } }
        if constexpr (decltype(masktag)::value) {
        const int kbase = kt * 64 + fr;
#pragma unroll
        for (int j = 0; j < 4; ++j) {
            const int qi = q_idx0 + wave * 16 + fq * 4 + j;
            float tmax = -1e30f;
#pragma unroll
            for (int n = 0; n < 4; ++n) { const int delta = qi - (kbase + n * 16); const bool valid = (unsigned)delta <= (unsigned)maxdelta;
                const float sv = valid ? s[n][j] - bslope * (float)delta : -1e30f; s[n][j] = sv; tmax = fmaxf(tmax, sv); }
            tmax = row16_max(tmax);
            const float mn = fmaxf(m_run[j], tmax), alpha = __builtin_amdgcn_exp2f(m_run[j] - mn);
            m_run[j] = mn;
            float psum = 0.f;
#pragma unroll
            for (int n = 0; n < 4; ++n) { const float p = s[n][j] > -1e29f ? __builtin_amdgcn_exp2f(s[n][j] - mn) : 0.f; psum += p;
                *(LAS bf16_t*)(Pw + ((fq * 4 + j) * 72 + n * 16 + fr) * 2) = f2bf(p); }
            l_run[j] = l_run[j] * alpha + psum;
#pragma unroll
            for (int d = 0; d < 8; ++d) o[d][j] *= alpha;
        }
        } else {
            float mn[4];
#pragma unroll
            for (int j = 0; j < 4; ++j) { float tmax = fmaxf(fmaxf(s[0][j], s[1][j]), fmaxf(s[2][j], s[3][j])); tmax = row16_max(tmax); mn[j] = fmaxf(m_run[j], tmax); }
#pragma unroll
            for (int j = 0; j < 4; ++j) { const float alpha = __builtin_amdgcn_exp2f(m_run[j] - mn[j]); m_run[j] = mn[j];
                float psum = 0.f;
#pragma unroll
                for (int n = 0; n < 4; ++n) { const float p = __builtin_amdgcn_exp2f(s[n][j] - mn[j]); psum += p;
                    *(LAS bf16_t*)(Pw + ((fq * 4 + j) * 72 + n * 16 + fr) * 2) = f2bf(p); }
                l_run[j] = l_run[j] * alpha + psum;
#pragma unroll
                for (int d = 0; d < 8; ++d) o[d][j] *= alpha; }
        }
        LDS_FENCE();
        { bf16x8 pf[2], vf[2][4];
          const LAS unsigned char* vbase_p = Vb + cur * VBYTES + (fr * 72 + fq * 8) * 2;
          pf[0] = *(const LAS bf16x8*)(Pw + (fr * 72 + fq * 8) * 2); pf[1] = *(const LAS bf16x8*)(Pw + (fr * 72 + 32 + fq * 8) * 2);
#pragma unroll
          for (int d4 = 0; d4 < 4; ++d4) vf[0][d4] = *(const LAS bf16x8*)(vbase_p + (d4 * 16 * 72) * 2);
#pragma unroll
          for (int gI = 0; gI < 4; ++gI) {
              if (gI + 1 < 4) {
#pragma unroll
                  for (int d4 = 0; d4 < 4; ++d4) vf[(gI + 1) & 1][d4] = *(const LAS bf16x8*)(vbase_p + ((((gI + 1) & 1) * 4 + d4) * 16 * 72 + ((gI + 1) >> 1) * 32) * 2); }
              __builtin_amdgcn_sched_barrier(0);
#pragma unroll
              for (int d4 = 0; d4 < 4; ++d4) o[(gI & 1) * 4 + d4] = __builtin_amdgcn_mfma_f32_16x16x32_bf16(pf[gI >> 1], vf[gI & 1][d4], o[(gI & 1) * 4 + d4], 0, 0, 0);
              __builtin_amdgcn_sched_barrier(0);
          } }
        if (kt + 1 < kt_hi) ATT_STORE(cur ^ 1);
        __syncthreads();
    };
    { const int kt_int = (maxdelta < (1 << 29)) ? kt_lo : min(kt_hi, max(kt_lo, q_idx0 >> 6));
      for (int kt = kt_lo; kt < kt_int; ++kt) tile_step(std::integral_constant<bool, false>{}, kt);
      for (int kt = kt_int; kt < kt_hi; ++kt) tile_step(std::integral_constant<bool, true>{}, kt); }
#undef ATT_LOAD
#undef ATT_STORE
    const int L = SEQ >> dsh;
#pragma unroll
    for (int j = 0; j < 4; ++j) {
        float lt = l_run[j]; lt += __shfl_xor(lt, 1); lt += __shfl_xor(lt, 2); lt += __shfl_xor(lt, 4); lt += __shfl_xor(lt, 8);
        const float inv = lt > 0.f ? 1.f / lt : 0.f, lse = lt > 0.f ? (m_run[j] + __log2f(lt)) * 0.6931471805599453f : -1e30f;
        const int p = q_idx0 + wave * 16 + fq * 4 + j, r = p / L, m = p - r * L, srow = (m << dsh) + r;
        bf16_t* orow = Op + (size_t)srow * 512 + head * 128 + fr;
#pragma unroll
        for (int d = 0; d < 8; ++d) orow[d * 16] = f2bf(o[d][j] * inv);
        if (fr == 0) Lp[srow * 4 + head] = lse;
    }
}

__device__ __forceinline__ f32x4 ld4bf(const bf16_t* p) { const u32x2 u = *(const u32x2*)p; return (f32x4){bflo(u.x), bfhi(u.x), bflo(u.y), bfhi(u.y)}; }
__device__ __forceinline__ void phase_combine(KP P) {
    const bf16_t* proj = (const bf16_t*)(P->ws + W_PROJ);
    bf16_t* ys = (bf16_t*)(P->ws + W_YS);
    const bf16_t* oA = (const bf16_t*)(P->ws + W_OA); const float* lA = (const float*)(P->ws + W_LSEA);
    const bf16_t* oB = (const bf16_t*)(P->ws + W_OB); const float* lB = (const float*)(P->ws + W_LSEB);
    const int tid = fresh_tid(), skip = gridDim.x > 128 ? 64 : 0;
    if ((int)blockIdx.x < skip) return;
    for (int idx = ((int)blockIdx.x - skip) * 512 + tid; idx < SEQ * 256; idx += ((int)gridDim.x - skip) * 512) {
        const int s = idx >> 8, cg4 = idx & 255, br = cg4 >> 7, c4 = (cg4 & 127) * 4, j = c4 >> 7;
        f32x4 o; u32x2 zz;
        if (br == 0) {
            const float l0 = lA[s * 4 + j], l1 = lA[(SEQ + s) * 4 + j], l2 = lA[(2 * SEQ + s) * 4 + j];
            const float mx = fmaxf(l0, fmaxf(l1, l2)); const float w0 = __expf(l0 - mx), w1 = __expf(l1 - mx), w2 = __expf(l2 - mx); const float inv = 1.f / (w0 + w1 + w2);
            const f32x4 a = ld4bf(oA + (size_t)s * 512 + c4), b = ld4bf(oA + ((size_t)SEQ + s) * 512 + c4), c = ld4bf(oA + ((size_t)2 * SEQ + s) * 512 + c4);
            o = (a * w0 + b * w1 + c * w2) * inv;
            zz = *(const u32x2*)(proj + (size_t)s * NP + O_AZ + c4);
        } else {
            const float l0 = lB[s * 4 + j], l1 = lB[(SEQ + s) * 4 + j];
            const float mx = fmaxf(l0, l1); const float w0 = __expf(l0 - mx), w1 = __expf(l1 - mx); const float inv = 1.f / (w0 + w1);
            const f32x4 a = ld4bf(oB + (size_t)s * 512 + c4), b = ld4bf(oB + ((size_t)SEQ + s) * 512 + c4);
            o = (a * w0 + b * w1) * inv;
            zz = *(const u32x2*)(proj + (size_t)s * NP + O_BZ + c4);
        }
        u32x2 w; w.x = cvt_pk_bf16(o[0] * siluf_(bflo(zz.x)), o[1] * siluf_(bfhi(zz.x))); w.y = cvt_pk_bf16(o[2] * siluf_(bflo(zz.y)), o[3] * siluf_(bfhi(zz.y)));
        *(u32x2*)(ys + (size_t)s * DM + br * 512 + c4) = w;
    }
}

#define XB_TMO      128
#define XB_XCNT(j)  (256  + 64 * (j))
#define XB_XSUB(j)  (1280 + 64 * (j))
#define XB_XGEN(j)  (2304 + 64 * (j))
#define XB_TOP      3328
#define XB_TOPGEN   3392
#define XCD_BAR_WORDS 3456
#define XB_SPIN_CAP (1u << 20)
__device__ __forceinline__ unsigned xb_ld(unsigned* p)              { return __hip_atomic_load(p, __ATOMIC_RELAXED, __HIP_MEMORY_SCOPE_AGENT); }
__device__ __forceinline__ unsigned xb_add(unsigned* p, unsigned v) { return __hip_atomic_fetch_add(p, v, __ATOMIC_RELAXED, __HIP_MEMORY_SCOPE_AGENT); }
__device__ __forceinline__ unsigned xb_xcc_id() { return (unsigned)__builtin_amdgcn_s_getreg((3 << 11) | 20) & 0xFu; }
#define XB_SPIN(cond, bar) do { unsigned _sp = 0; while (cond) { __builtin_amdgcn_s_sleep(1); \
    if ((++_sp & 255u) == 0u) { if (xb_ld(&(bar)[XB_TMO])) break; if (_sp > XB_SPIN_CAP) { atomicAdd(&(bar)[XB_TMO], 1u); break; } } } } while (0)
struct XcdBarrier { unsigned* bar; unsigned x; volatile LAS unsigned* st; };
__device__ __forceinline__ XcdBarrier xcd_barrier_post(unsigned* bar, volatile LAS unsigned* st) {
    XcdBarrier b; b.bar = bar; b.x = xb_xcc_id(); b.st = st;
    if (threadIdx.x == 0) (void)xb_add(&bar[XB_XCNT(b.x)], 1u);
    return b;
}
__device__ __forceinline__ void xcd_barrier_complete(unsigned* bar, unsigned x, unsigned& nloc, unsigned& nx) {
    const unsigned G = gridDim.x * gridDim.y * gridDim.z;
    unsigned sum, cnt, mine, sp = 0u;
    for (;;) {
        sum = 0u; cnt = 0u; mine = 0u;
#pragma unroll
        for (unsigned j = 0; j < 16; ++j) { const unsigned c = xb_ld(&bar[XB_XCNT(j)]); sum += c; cnt += (c > 0u) ? 1u : 0u; mine = (j == x) ? c : mine; }
        if (sum == G) break;
        __builtin_amdgcn_s_sleep(1);
        if ((++sp & 255u) == 0u) { if (xb_ld(&bar[XB_TMO])) break; if (sp > XB_SPIN_CAP) { atomicAdd(&bar[XB_TMO], 1u); break; } }
    }
    nloc = mine > 0u ? mine : 1u; nx = cnt > 0u ? cnt : 1u;
}
__device__ __forceinline__ void xcd_barrier(const XcdBarrier& b) {
    asm volatile("s_waitcnt vmcnt(0)" ::: "memory");
    __syncthreads();
    if (threadIdx.x == 0) {
        unsigned* bar = b.bar;
        __builtin_amdgcn_s_waitcnt(0);
        unsigned nloc = b.st[0], nx = b.st[1];
        if (nloc == 0u) { xcd_barrier_complete(bar, b.x, nloc, nx); b.st[0] = nloc; b.st[1] = nx; }
        const unsigned old = xb_add(&bar[XB_XSUB(b.x)], 1u);
        const unsigned gen = old / nloc;
        if (old + 1u == (gen + 1u) * nloc) {
            __builtin_amdgcn_fence(__ATOMIC_RELEASE, "agent");
            asm volatile("s_waitcnt vmcnt(0)" ::: "memory");
            const unsigned og = xb_add(&bar[XB_TOP], 1u);
            const unsigned tg = og / nx;
            if (og + 1u == (tg + 1u) * nx) xb_add(&bar[XB_TOPGEN], 1u);
            else XB_SPIN(xb_ld(&bar[XB_TOPGEN]) == tg, bar);
            __builtin_amdgcn_fence(__ATOMIC_ACQUIRE, "agent");
            xb_add(&bar[XB_XGEN(b.x)], 1u);
            asm volatile("s_waitcnt vmcnt(0)" ::: "memory");
        } else {
            XB_SPIN(xb_ld(&bar[XB_XGEN(b.x)]) == gen, bar);
            __builtin_amdgcn_fence(__ATOMIC_ACQUIRE, "agent");
            asm volatile("s_waitcnt vmcnt(0)" ::: "memory");
        }
    }
    __syncthreads();
}

__global__ void __launch_bounds__(512, 2) fwd_mega(Params Pk) {
    extern __shared__ __attribute__((aligned(16))) unsigned char shm[];
    LAS unsigned char* lds = (LAS unsigned char*)shm;
    cg::grid_group grid = cg::this_grid();
    const int G = gridDim.x, bid = blockIdx.x, ngw = G * 8;
    volatile LAS unsigned* xst = (volatile LAS unsigned*)(lds + LDS_BYTES - 16);
    if (threadIdx.x == 0) { xst[0] = 0u; xst[1] = 0u; }
    __syncthreads();
    const XcdBarrier xb = xcd_barrier_post((unsigned*)(fresh_params()->ws + W_BAR), xst);
#define GSYNC() xcd_barrier(xb)
    for (int rp = 0; rp < REP_W; ++rp) { KP P = fresh_params(); phase_weights(P, lds); }
    for (int l = 0; l < DEPTH; ++l) {
        for (int rp = 0; rp < REP_P1; ++rp) { KP P = fresh_params(); const float* xin = l == 0 ? P->in[0] : P->out; phase_norm(xin, P->in[2] + l * DM, (bf16_t*)(P->ws + W_H)); }
        if (G == 0x7fffffff) grid.sync();
        GSYNC();
        for (int rp = 0; rp < REP_P2; ++rp) { KP P = fresh_params(); bf16_t* proj = (bf16_t*)(P->ws + W_PROJ); pg8::Gemm g{(const bf16_t*)(P->ws + W_H), (const bf16_t*)(P->ws + W_WIN + l * SZ_WIN), SEQ, NP, DM};
          pg8::StaticOrder S; S.init(SEQ, NP, G, bid);
          EpiProj E{proj, P->in[27] + l * 4 * DM};
          pg8::gemm_phase(lds, g, S, E); GSYNC(); }
        for (int rp = 0; rp < REP_P3; ++rp) { KP P = fresh_params();
        { const int tid = fresh_tid(), lane = tid & 63, gw = bid * 8 + (tid >> 6); for (int r2 = 0; r2 < REP_A; ++r2) for (int it = gw; it < 1536; it += ngw) a_prep_item(P, l, it, lane, lds + (tid >> 6) * 16384); }
        { const int tid = fresh_tid(), lane = tid & 63, gw = bid * 8 + (tid >> 6); for (int it = gw; it < SEQ; it += ngw) b_prep1_cq(P, l, it, lane); for (int it = gw; it < SEQ / 4; it += ngw) b_prep1_ckv(P, l, it, lane); }
        { const int tid = fresh_tid(), lane = tid & 63, gw = bid * 8 + (tid >> 6); for (int r2 = 0; r2 < REP_D1; ++r2) for (int it = gw; it < 4096; it += ngw) s5_item<false>(P, l, it, lane, lds + (tid >> 6) * 12800); }
        __syncthreads();
        for (int it = bid; it < 512; it += G) c1_item(P, l, it, lds); GSYNC(); }
        for (int rp = 0; rp < REP_P4; ++rp) { KP P = fresh_params(); const int scanW = 32, gemmW = G - scanW;
          if (bid < gemmW) {
              { pg8::Gemm g{(const bf16_t*)(P->ws + W_CQN), (const bf16_t*)(P->ws + W_WUQ + l * SZ_WUQ), SEQ, 768, 512};
                pg8::StaticOrder S; S.init(SEQ, 768, gemmW, bid); EpiBf16 E{(bf16_t*)(P->ws + W_QRAW), 768}; pg8::gemm_phase(lds, g, S, E); }
              { pg8::Gemm g{(const bf16_t*)(P->ws + W_CKVN), (const bf16_t*)(P->ws + W_WUKV + l * SZ_WUKV), SEQ, 1024, 256};
                pg8::StaticOrder S; S.init(SEQ, 1024, gemmW, (bid + gemmW - 96) % gemmW); EpiKV E{(bf16_t*)(P->ws + W_KVRAW), (bf16_t*)(P->ws + W_VBT)}; pg8::gemm_phase(lds, g, S, E); }
          } else {
              const int tid = fresh_tid(), nst = scanW * 512;
              LAS float* metaL = (LAS float*)lds;
              for (int i = tid; i < 1024; i += 512) metaL[i] = ((const float*)(P->ws + W_META))[i];
              __syncthreads();
              { const int e = (bid - gemmW - (scanW - 4)) * 512 + tid; if (e >= 0 && e < 2048) d2_elem(P, l, e); }
              c2_multi(P, (bid - gemmW) * 512 + tid, nst, metaL);
          }
          __syncthreads();
          unsigned* ticket = (unsigned*)(P->ws + W_BAR + 14336) + l * 64;
          volatile LAS int* tk = (volatile LAS int*)(lds + LDS_BYTES - 32);
          for (;;) {
              if (threadIdx.x == 0) tk[0] = (int)atomicAdd(ticket, 1u);
              __syncthreads();
              const int it = tk[0];
              __syncthreads();
              if (it >= 768) break;
              const int hh = it >> 6, nq = it & 63, g = hh >> 2, dsh = 2 * g, L = SEQ >> dsh, p0 = nq * 128, n_in = (p0 & (L - 1)) >> 7;
              const int kt_hi = p0 / 64 + 2, kt_lo = n_in == 0 ? p0 / 64 : p0 / 64 - 2;
              const float slope = exp2f(-8.f * (float)(hh + 1) / 12.f) * (float)(1 << dsh) * 1.4426950408889634f;
              attn_block<128>(lds, (const bf16_t*)(P->ws + W_QA) + ((size_t)hh * SEQ + p0) * 128, (const bf16_t*)(P->ws + W_KA) + (size_t)hh * SEQ * 128,
                              (const bf16_t*)(P->ws + W_VAT) + (size_t)hh * 128 * SEQ, p0, kt_lo, kt_hi, 128, slope, dsh,
                              (bf16_t*)(P->ws + W_OA) + (size_t)g * SEQ * 512, (float*)(P->ws + W_LSEA) + (size_t)g * SEQ * 4, hh & 3);
          } GSYNC(); }
        for (int rp = 0; rp < REP_P5; ++rp) { KP P = fresh_params();
        { const int tid = fresh_tid(), lane = tid & 63, gw = bid * 8 + (tid >> 6); for (int it = gw; it < SEQ; it += ngw) b_prep2_item(P, l, it, lane); }
        { const int tid = fresh_tid(), lane = tid & 63, gw = bid * 8 + (tid >> 6); for (int r2 = 0; r2 < REP_D3; ++r2) for (int it = gw; it < 4096; it += ngw) s5_item<true>(P, l, it, lane, lds + (tid >> 6) * 12800); }
        __syncthreads();
        for (int r2 = 0; r2 < REP_C3; ++r2) for (int it = bid; it < 512; it += G) c3_item(P, l, it, lds); GSYNC(); }
        for (int rp = 0; rp < REP_P6; ++rp) {
        for (int slot = bid; slot < 256; slot += G) { KP P = fresh_params();
            const int h = slot & 3, part = (slot >> 2) & 1, i0 = slot >> 3;
#pragma unroll 1
            for (int rep = 0; rep < 2; ++rep) {
                const int i = rep ? 63 - i0 : i0, nkb = i + 1, h0 = (nkb + 1) >> 1;
                const int kt_lo = part ? 2 * h0 : 0, kt_hi = part ? 2 * nkb : 2 * h0;
                attn_block<192>(lds, (const bf16_t*)(P->ws + W_QB) + ((size_t)h * SEQ + i * 128) * 192, (const bf16_t*)(P->ws + W_KB) + (size_t)h * SEQ * 192,
                                (const bf16_t*)(P->ws + W_VBT) + (size_t)h * 128 * SEQ, i * 128, kt_lo, kt_hi, 1 << 30, 0.f, 0,
                                (bf16_t*)(P->ws + W_OB) + (size_t)part * SEQ * 512, (float*)(P->ws + W_LSEB) + (size_t)part * SEQ * 4, h);
            }
        }
        GSYNC(); }
        for (int rp = 0; rp < REP_P7; ++rp) {
        { KP P = fresh_params(); bf16_t* proj = (bf16_t*)(P->ws + W_PROJ); pg8::Gemm g{(const bf16_t*)(P->ws + W_YD), (const bf16_t*)(P->ws + W_WGLU + l * SZ_WGLU), SEQ, 512, 512};
          pg8::StaticOrder S; S.init(SEQ, 512, G, bid);
          EpiGlu E{(const bf16_t*)(P->ws + W_YD), proj, P->in[25] + l * 512, (bf16_t*)(P->ws + W_YS)};
          pg8::gemm_phase(lds, g, S, E); }
        { KP P = fresh_params(); phase_combine(P); }
        GSYNC(); }
        for (int rp = 0; rp < REP_P8; ++rp) { KP P = fresh_params(); bf16_t* proj = (bf16_t*)(P->ws + W_PROJ); pg8::Gemm g{(const bf16_t*)(P->ws + W_YS), (const bf16_t*)(P->ws + W_WUP + l * SZ_WSQ), SEQ, DM, DM};
          pg8::StaticOrder S; S.init(SEQ, DM, G, bid);
          EpiUp E{proj, (bf16_t*)(P->ws + W_MERGED)};
          pg8::gemm_phase(lds, g, S, E); GSYNC(); }
        for (int rp = 0; rp < REP_SYNC; ++rp) GSYNC();
        for (int rp = 0; rp < (l == 0 ? REP_P9 : 1); ++rp) { KP P = fresh_params(); const float* xin = l == 0 ? P->in[0] : P->out; pg8::Gemm g{(const bf16_t*)(P->ws + W_MERGED), (const bf16_t*)(P->ws + W_WOUT + l * SZ_WSQ), SEQ, DM, DM};
          pg8::StaticOrder S; S.init(SEQ, DM, G, bid);
          EpiOut E{xin, P->out};
          pg8::gemm_phase(lds, g, S, E); GSYNC(); }
    }
}

extern "C" void kernel_launch(void* const* d_in, const int* in_sizes, int n_in, void* d_out, int out_size, void* d_ws, size_t ws_size, hipStream_t stream) {
    static int grid_blocks = 0;
    if (!grid_blocks) {
        int dev = 0, cus = 0, per_cu = 0;
        (void)hipGetDevice(&dev);
        (void)hipDeviceGetAttribute(&cus, hipDeviceAttributeMultiprocessorCount, dev);
        (void)hipFuncSetAttribute((const void*)fwd_mega, hipFuncAttributeMaxDynamicSharedMemorySize, LDS_BYTES);
        (void)hipOccupancyMaxActiveBlocksPerMultiprocessor(&per_cu, (const void*)fwd_mega, 512, LDS_BYTES);
        (void)hipGetLastError();
        grid_blocks = cus > 0 ? cus : 256;
        if (ws_size < W_END) fprintf(stderr, "workspace too small: %zu < %zu\n", ws_size, (size_t)W_END);
        fprintf(stderr, "grid %d (cus %d per_cu %d)\n", grid_blocks, cus, per_cu);
    }
    (void)hipMemsetAsync((unsigned char*)d_ws + W_BAR, 0, 16384, stream);
    Params p{};
    for (int i = 0; i < 29; ++i) p.in[i] = (const float*)d_in[i];
    p.out = (float*)d_out; p.ws = (unsigned char*)d_ws;
    void* args[] = {&p};
    hipError_t e = hipLaunchCooperativeKernel((const void*)fwd_mega, dim3(grid_blocks), dim3(512), args, LDS_BYTES, stream);
    if (e != hipSuccess) fprintf(stderr, "cooperative launch failed: %s\n", hipGetErrorString(e));
}
```

```cpp
#include <hip/hip_runtime.h>
#include <hip/hip_cooperative_groups.h>
#include <cstdio>
#include <type_traits>
namespace cg = cooperative_groups;

#define LAS __attribute__((address_space(3)))
typedef unsigned short bf16_t;
typedef short bf16x8 __attribute__((ext_vector_type(8)));
typedef float f32x4 __attribute__((ext_vector_type(4)));
typedef unsigned u32x4 __attribute__((ext_vector_type(4)));
typedef unsigned u32x2 __attribute__((ext_vector_type(2)));

constexpr int SEQ = 8192, DM = 2048, NIN = 17544, NP = 17664, NG0 = 9352, GATE0 = 9472, DEPTH = 4;
constexpr int O_AQ = 0, O_AK = 1536, O_AV = 3072, O_AZ = 4608, O_BCQ = 5120, O_BCKV = 5568, O_BKR = 5696, O_BZ = 5760, O_CQK = 6272,
              O_CV = 6784, O_CI = 7296, O_CF = 7300, O_CO = 7304, O_CZ = 7816, O_DU = 8328, O_DZ = 8840;
constexpr float EPS = 1e-6f;
constexpr int LDS_BYTES = 144 * 1024;
#define REP_W 1
#define REP_P1 1
#define REP_SYNC 0
#define REP_P9 1
#define REP_A 1
#define REP_D1 1
#define REP_D3 1
#define REP_C3 1
#define REP_P2 1
#define REP_P3 1
#define REP_P4 1
#define REP_P5 1
#define REP_P6 1
#define REP_P7 1
#define REP_P8 1

constexpr size_t al(size_t x) { return (x + 255) & ~(size_t)255; }
constexpr size_t SZ_WIN = (size_t)NP * DM * 2, SZ_WSQ = (size_t)DM * DM * 2, SZ_WUQ = (size_t)768 * 512 * 2, SZ_WUKV = (size_t)1024 * 256 * 2, SZ_WGLU = (size_t)512 * 512 * 2;
constexpr size_t W_WIN = 0;
constexpr size_t W_WUP = W_WIN + DEPTH * SZ_WIN;
constexpr size_t W_WOUT = W_WUP + DEPTH * SZ_WSQ;
constexpr size_t W_WUQ = W_WOUT + DEPTH * SZ_WSQ;
constexpr size_t W_WUKV = W_WUQ + DEPTH * SZ_WUQ;
constexpr size_t W_WGLU = W_WUKV + DEPTH * SZ_WUKV;
constexpr size_t W_H = W_WGLU + DEPTH * SZ_WGLU;
constexpr size_t W_PROJ = W_H + (size_t)SEQ * DM * 2;
constexpr size_t W_QA = W_PROJ + (size_t)SEQ * NP * 2;
constexpr size_t W_KA = W_QA + (size_t)12 * SEQ * 128 * 2;
constexpr size_t W_VAT = W_KA + (size_t)12 * SEQ * 128 * 2;
constexpr size_t W_CQN = W_VAT + (size_t)12 * SEQ * 128 * 2;
constexpr size_t W_CKVN = W_CQN + (size_t)SEQ * 512 * 2;
constexpr size_t W_QRAW = W_CKVN + (size_t)SEQ * 256 * 2;
constexpr size_t W_KVRAW = W_QRAW + (size_t)SEQ * 768 * 2;
constexpr size_t W_QB = W_KVRAW + (size_t)SEQ * 1024 * 2;
constexpr size_t W_KB = W_QB + (size_t)4 * SEQ * 192 * 2;
constexpr size_t W_VBT = W_KB + (size_t)4 * SEQ * 192 * 2;
constexpr size_t W_OA = W_VBT + (size_t)4 * 128 * SEQ * 2;
constexpr size_t W_LSEA = W_OA + (size_t)3 * SEQ * 512 * 4;
constexpr size_t W_OB = W_LSEA + (size_t)3 * SEQ * 4 * 4;
constexpr size_t W_LSEB = W_OB + (size_t)2 * SEQ * 512 * 4;
constexpr size_t W_CLOC = W_LSEB + (size_t)2 * SEQ * 4 * 4;
constexpr size_t W_CST = W_CLOC + (size_t)512 * 8192 * 4;
constexpr size_t W_NLOC = W_CST + (size_t)512 * 8192 * 4;
constexpr size_t W_NST = W_NLOC + (size_t)512 * 64 * 4;
constexpr size_t W_META = W_NST + (size_t)512 * 64 * 4;
constexpr size_t W_MST = W_META + al(512 * 2 * 4);
constexpr size_t W_XEND = W_MST + al(512 * 4);
constexpr size_t W_XST = W_XEND + (size_t)128 * 2048 * 2 * 4;
constexpr size_t W_YD = W_XST + (size_t)128 * 2048 * 2 * 4;
constexpr size_t W_YS = W_YD + (size_t)SEQ * 512 * 2;
constexpr size_t W_MERGED = W_YS + (size_t)SEQ * DM * 2;
constexpr size_t W_BAR = W_MERGED + (size_t)SEQ * DM * 2;
constexpr size_t W_END = W_BAR + 16384;

struct Params { const float* in[29]; float* out; unsigned char* ws; };
typedef const Params __attribute__((address_space(4))) * KP;
__device__ __forceinline__ KP fresh_params() { KP p = (KP)__builtin_amdgcn_kernarg_segment_ptr(); asm volatile("" : "+s"(p)); return p; }

__device__ __forceinline__ float bflo(unsigned u) { return __uint_as_float(u << 16); }
__device__ __forceinline__ float bfhi(unsigned u) { return __uint_as_float(u & 0xffff0000u); }
__device__ __forceinline__ float bf2f(bf16_t b) { return __uint_as_float(((unsigned)b) << 16); }
__device__ __forceinline__ unsigned cvt_pk_bf16(float lo, float hi) { unsigned r; asm volatile("s_nop 0\n\tv_cvt_pk_bf16_f32 %0, %1, %2" : "=v"(r) : "v"(lo), "v"(hi)); return r; }
__device__ __forceinline__ bf16_t f2bf(float f) { return (bf16_t)(cvt_pk_bf16(f, 0.f) & 0xffffu); }
__device__ __forceinline__ void ld8(const bf16_t* p, float (&v)[8]) {
    const u32x4 u = *(const u32x4*)p;
    v[0] = bflo(u.x); v[1] = bfhi(u.x); v[2] = bflo(u.y); v[3] = bfhi(u.y); v[4] = bflo(u.z); v[5] = bfhi(u.z); v[6] = bflo(u.w); v[7] = bfhi(u.w);
}
__device__ __forceinline__ void st8(bf16_t* p, const float (&v)[8]) {
    u32x4 u; u.x = cvt_pk_bf16(v[0], v[1]); u.y = cvt_pk_bf16(v[2], v[3]); u.z = cvt_pk_bf16(v[4], v[5]); u.w = cvt_pk_bf16(v[6], v[7]);
    *(u32x4*)p = u;
}
__device__ __forceinline__ float sigmoidf_(float x) { return __builtin_amdgcn_rcpf(1.f + __expf(-x)); }
__device__ __forceinline__ float siluf_(float x) { return x * sigmoidf_(x); }
__device__ __forceinline__ float wave_sum(float v) {
#pragma unroll
    for (int o = 1; o < 64; o <<= 1) v += __shfl_xor(v, o);
    return v;
}
__device__ __forceinline__ float wave_max(float v) {
#pragma unroll
    for (int o = 1; o < 64; o <<= 1) v = fmaxf(v, __shfl_xor(v, o));
    return v;
}
__device__ __forceinline__ int fresh_tid() { int t = threadIdx.x; asm volatile("" : "+v"(t)); return t; }
template <int CTRL> __device__ __forceinline__ float dppf(float v) { return __int_as_float(__builtin_amdgcn_update_dpp(0, __float_as_int(v), CTRL, 0xf, 0xf, true)); }
__device__ __forceinline__ float row16_max(float v) { v = fmaxf(v, dppf<0x128>(v)); v = fmaxf(v, dppf<0x124>(v)); v = fmaxf(v, dppf<0x122>(v)); v = fmaxf(v, dppf<0x121>(v)); return v; }
__device__ __forceinline__ float row16_sum(float v) { v += dppf<0x128>(v); v += dppf<0x124>(v); v += dppf<0x122>(v); v += dppf<0x121>(v); return v; }
#define LDS_FENCE() asm volatile("s_waitcnt lgkmcnt(0)" ::: "memory")

namespace pg8 {
constexpr int BM = 256, BK = 64, HALF = 128, HTB = HALF * BK * 2, STAGE_BYTES = 8 * HTB, NXCD = 8, WGM = 4;
__device__ __forceinline__ int lds_byte(int r, int c) { const int st = (r >> 4) * 2 + (c >> 5), rr = r & 15, cc = c & 31, ob = rr * 64 + cc * 2; return st * 1024 + (ob ^ (((ob >> 9) & 1) << 5)); }
__device__ __forceinline__ void stage_rc(int b, int& R, int& C) { const int st = b / 1024, sb = b % 1024, swz = sb ^ (((sb >> 9) & 1) << 5); R = (st >> 1) * 16 + swz / 64; C = (st & 1) * 32 + (swz % 64) / 2; }
__device__ __forceinline__ int perm32(int rho) { const int n = rho >> 4, i = rho & 15; return 8 * (i >> 2) + 4 * n + (i & 3); }
struct Unit { int pm, pn; };
struct Gemm { const bf16_t* A; const bf16_t* Bt; int M, N, K; };
struct StaticOrder {
    int nM, nN, nwg, G, c;
    __device__ void init(int M, int N, int G_, int c_) { nM = M / BM; nN = N / BM; nwg = nM * nN; G = G_; c = c_; }
    __device__ bool next(int i, Unit& u) const {
        const long L = (long)i * G + c; if (L >= nwg) return false;
        int wgid = (int)L; { const int q = nwg / NXCD, r = nwg % NXCD, xcd = wgid % NXCD, off = wgid / NXCD; wgid = (xcd < r ? xcd * (q + 1) : r * (q + 1) + (xcd - r) * q) + off; }
        const int nig = WGM * nN, gid = wgid / nig, fm = gid * WGM, gsz = (nM - fm) < WGM ? (nM - fm) : WGM;
        u.pm = fm + ((wgid % nig) % gsz); u.pn = (wgid % nig) / gsz; return true;
    }
};

template <class Epi>
__device__ __forceinline__ void gemm_phase(LAS unsigned char* lds, const Gemm g, const StaticOrder& S, const Epi& E) {
    const int tid = fresh_tid(), wid = __builtin_amdgcn_readfirstlane(tid >> 6), lane = tid & 63, wr = wid >> 2, wc = wid & 3, fr = lane & 15, fq = lane >> 4;
    const int K = g.K, nt = K / BK;
    unsigned voffA[2], voffB[2];
#pragma unroll
    for (int i = 0; i < 2; ++i) { int R, C; stage_rc(tid * 16 + i * 8192, R, C); const int Rb = Epi::PERM ? ((R & ~31) + perm32(R & 31)) : R;
        voffA[i] = (unsigned)(R * K + C) * 2u; voffB[i] = (unsigned)(Rb * K + C) * 2u; }
    const size_t kstep = (size_t)(BK * 2);
    const size_t hstep = (size_t)HALF * K * 2;
    const size_t tstep = 2 * hstep;
    const unsigned ldsw = (unsigned)wid * 1024u;
    const int aoff = lds_byte(wr * 64 + fr, fq * 8), boff = lds_byte(wc * 32 + fr, fq * 8);
#define PG8_SA(b, h) (((b) * 2 + (h)) * HTB)
#define PG8_SB(b, h) ((4 + (b) * 2 + (h)) * HTB)
#define PG8_STAGE_(bufoff, gbase, voff) do { _Pragma("unroll") for (int _i = 0; _i < 2; ++_i) \
        __builtin_amdgcn_global_load_lds((const unsigned*)((const char*)(gbase) + (voff)[_i]), (LAS unsigned*)(lds + (bufoff) + ldsw + _i * 8192), 16, 0, 0); } while (0)
#define PG8_STAGE(bufoff, gbase) PG8_STAGE_(bufoff, gbase, voffA)
#define PG8_STAGEB(bufoff, gbase) PG8_STAGE_(bufoff, gbase, voffB)
#define PG8_LDA(dst, b, h) do { _Pragma("unroll") for (int m = 0; m < 4; ++m) _Pragma("unroll") for (int k = 0; k < 2; ++k) dst[m][k] = *(const LAS bf16x8*)(lds + PG8_SA(b, h) + aoff + m * 2048 + k * 1024); } while (0)
#define PG8_LDB(dst, b, h) do { _Pragma("unroll") for (int n = 0; n < 2; ++n) _Pragma("unroll") for (int k = 0; k < 2; ++k) dst[n][k] = *(const LAS bf16x8*)(lds + PG8_SB(b, h) + boff + n * 2048 + k * 1024); } while (0)
#define PG8_MMA(ai, bj, At, Bt) do { __builtin_amdgcn_s_setprio(1); _Pragma("unroll") for (int m = 0; m < 4; ++m) _Pragma("unroll") for (int n = 0; n < 2; ++n) _Pragma("unroll") for (int k = 0; k < 2; ++k) \
        acc[ai][bj][m][n] = __builtin_amdgcn_mfma_f32_16x16x32_bf16(Bt[n][k], At[m][k], acc[ai][bj][m][n], 0, 0, 0); __builtin_amdgcn_s_setprio(0); } while (0)
#define PG8_WAIT_V(n) asm volatile("s_waitcnt vmcnt(" #n ")" ::: "memory")
#define PG8_WAIT_L(n) asm volatile("s_waitcnt lgkmcnt(" #n ")" ::: "memory")
#define PG8_BAR __builtin_amdgcn_s_barrier()
#define PG8_SCHED __builtin_amdgcn_sched_barrier(0)
    Unit cur, nxt; int ui = 0;
    if (!S.next(0, cur)) return;
    f32x4 acc[2][2][4][2];
#pragma unroll
    for (int a = 0; a < 2; ++a)
#pragma unroll
        for (int b = 0; b < 2; ++b)
#pragma unroll
            for (int m = 0; m < 4; ++m)
#pragma unroll
                for (int n = 0; n < 2; ++n) acc[a][b][m][n] = (f32x4){0.f, 0.f, 0.f, 0.f};
    bf16x8 At[4][2], B0[2][2], B1[2][2];
    const char* cA = (const char*)g.A + (size_t)cur.pm * tstep; const char* cB = (const char*)g.Bt + (size_t)cur.pn * tstep;
    PG8_STAGEB(PG8_SB(0, 0), cB); PG8_STAGE(PG8_SA(0, 0), cA); PG8_STAGEB(PG8_SB(0, 1), cB + hstep); PG8_STAGE(PG8_SA(0, 1), cA + hstep);
    if (wr == 1) PG8_BAR;
    PG8_WAIT_V(4); PG8_BAR;
    PG8_STAGEB(PG8_SB(1, 0), cB + kstep); PG8_STAGE(PG8_SA(1, 0), cA + kstep); PG8_STAGEB(PG8_SB(1, 1), cB + hstep + kstep);
    PG8_WAIT_V(6); PG8_BAR;
    for (;;) {
        const bool has_next = S.next(ui + 1, nxt);
        const char* nA = has_next ? (const char*)g.A + (size_t)nxt.pm * tstep : cA; const char* nB = has_next ? (const char*)g.Bt + (size_t)nxt.pn * tstep : cB;
        for (int t = 0; t < nt; t += 2) {
            const bool last = (t == nt - 2);
            const char* a1 = cA + (size_t)(t + 1) * kstep;
            const char* a2 = last ? nA : cA + (size_t)(t + 2) * kstep; const char* b2 = last ? nB : cB + (size_t)(t + 2) * kstep;
            const char* a3 = a2 + kstep; const char* b3 = b2 + kstep;
            if constexpr (Epi::RESCALE) { if (t != 0 && (t & 7) == 0) { const int t2 = fresh_tid(); const int w2 = __builtin_amdgcn_readfirstlane(t2 >> 6); E.rescale(acc, cur, t >> 3, w2 >> 2, w2 & 3, t2 & 15, (t2 >> 4) & 3); } }
            PG8_LDB(B0, 0, 0); PG8_SCHED; PG8_LDA(At, 0, 0); PG8_STAGE(PG8_SA(1, 1), a1 + hstep);
            PG8_WAIT_L(8); PG8_BAR; PG8_WAIT_L(0); PG8_MMA(0, 0, At, B0); PG8_BAR; PG8_SCHED;
            PG8_LDB(B1, 0, 1); PG8_STAGEB(PG8_SB(0, 0), b2);
            PG8_BAR; PG8_WAIT_L(0); PG8_MMA(0, 1, At, B1); PG8_BAR;
            PG8_LDA(At, 0, 1); PG8_STAGE(PG8_SA(0, 0), a2);
            PG8_BAR; PG8_WAIT_L(0); PG8_MMA(1, 0, At, B0); PG8_BAR; PG8_SCHED;
            PG8_STAGEB(PG8_SB(0, 1), b2 + hstep);
            PG8_WAIT_V(6); PG8_BAR; PG8_MMA(1, 1, At, B1); PG8_BAR;
            PG8_LDB(B0, 1, 0); PG8_SCHED; PG8_LDA(At, 1, 0); PG8_STAGE(PG8_SA(0, 1), a2 + hstep);
            PG8_WAIT_L(8); PG8_BAR; PG8_WAIT_L(0); PG8_MMA(0, 0, At, B0); PG8_BAR; PG8_SCHED;
            PG8_LDB(B1, 1, 1); PG8_STAGEB(PG8_SB(1, 0), b3);
            PG8_BAR; PG8_WAIT_L(0); PG8_MMA(0, 1, At, B1); PG8_BAR;
            PG8_LDA(At, 1, 1); PG8_STAGE(PG8_SA(1, 0), a3);
            PG8_BAR; PG8_WAIT_L(0); PG8_MMA(1, 0, At, B0); PG8_BAR; PG8_SCHED;
            PG8_STAGEB(PG8_SB(1, 1), b3 + hstep);
            PG8_WAIT_V(6); PG8_BAR; PG8_MMA(1, 1, At, B1); PG8_BAR;
        }
        { const int t2 = fresh_tid(); const int w2 = __builtin_amdgcn_readfirstlane(t2 >> 6); E(acc, cur, w2 >> 2, w2 & 3, t2 & 15, (t2 >> 4) & 3); }
        if (!has_next) break;
#pragma unroll
        for (int a = 0; a < 2; ++a)
#pragma unroll
            for (int b = 0; b < 2; ++b)
#pragma unroll
                for (int m = 0; m < 4; ++m)
#pragma unroll
                    for (int n = 0; n < 2; ++n) acc[a][b][m][n] = (f32x4){0.f, 0.f, 0.f, 0.f};
        cur = nxt; cA = nA; cB = nB; ++ui;
    }
    PG8_WAIT_V(0);
    if (wr == 0) PG8_BAR;
    PG8_BAR;
#undef PG8_SA
#undef PG8_SB
#undef PG8_STAGE
#undef PG8_STAGEB
#undef PG8_STAGE_
#undef PG8_LDA
#undef PG8_LDB
#undef PG8_MMA
#undef PG8_WAIT_V
#undef PG8_WAIT_L
#undef PG8_BAR
#undef PG8_SCHED
}
}
using pg8::Unit;
typedef f32x4 AccT[2][2][4][2];

struct EpiProj {
    static constexpr bool RESCALE = false, PERM = true;
    bf16_t* O; const float* mb;
    __device__ __forceinline__ void operator()(AccT& acc, const Unit& u, int wr, int wc, int fr, int fq) const {
        int row0 = u.pm * 256 + wr * 64 + fr, col0 = u.pn * 256 + wc * 32 + 8 * fq;
        asm volatile("" : "+v"(row0), "+v"(col0));
        const bool gate = u.pn >= 37;
        f32x4 bv[2][2];
#pragma unroll
        for (int bj = 0; bj < 2; ++bj)
#pragma unroll
            for (int n = 0; n < 2; ++n) bv[bj][n] = gate ? *(const f32x4*)(mb + (col0 - GATE0) + bj * 128 + n * 4) : (f32x4){0.f, 0.f, 0.f, 0.f};
#pragma unroll
        for (int ai = 0; ai < 2; ++ai)
#pragma unroll
            for (int m = 0; m < 4; ++m) { bf16_t* rowp = O + (size_t)(row0 + ai * 128 + m * 16) * NP + col0;
#pragma unroll
                for (int bj = 0; bj < 2; ++bj) { f32x4 v0 = acc[ai][bj][m][0], v1 = acc[ai][bj][m][1];
                    if (gate) { v0 = v0 + bv[bj][0]; v1 = v1 + bv[bj][1];
                        v0[0] = sigmoidf_(v0[0]); v0[1] = sigmoidf_(v0[1]); v0[2] = sigmoidf_(v0[2]); v0[3] = sigmoidf_(v0[3]);
                        v1[0] = sigmoidf_(v1[0]); v1[1] = sigmoidf_(v1[1]); v1[2] = sigmoidf_(v1[2]); v1[3] = sigmoidf_(v1[3]); }
                    u32x4 w; w.x = cvt_pk_bf16(v0[0], v0[1]); w.y = cvt_pk_bf16(v0[2], v0[3]); w.z = cvt_pk_bf16(v1[0], v1[1]); w.w = cvt_pk_bf16(v1[2], v1[3]);
                    __builtin_nontemporal_store(w, (u32x4*)(rowp + bj * 128)); } }
    }
};
struct EpiBf16 {
    static constexpr bool RESCALE = false, PERM = true;
    bf16_t* O; int ldc;
    __device__ __forceinline__ void operator()(AccT& acc, const Unit& u, int wr, int wc, int fr, int fq) const {
        int row0 = u.pm * 256 + wr * 64 + fr, col0 = u.pn * 256 + wc * 32 + 8 * fq;
        asm volatile("" : "+v"(row0), "+v"(col0));
#pragma unroll
        for (int ai = 0; ai < 2; ++ai)
#pragma unroll
            for (int m = 0; m < 4; ++m) { bf16_t* rowp = O + (size_t)(row0 + ai * 128 + m * 16) * ldc + col0;
#pragma unroll
                for (int bj = 0; bj < 2; ++bj) { const f32x4 v0 = acc[ai][bj][m][0], v1 = acc[ai][bj][m][1];
                    u32x4 w; w.x = cvt_pk_bf16(v0[0], v0[1]); w.y = cvt_pk_bf16(v0[2], v0[3]); w.z = cvt_pk_bf16(v1[0], v1[1]); w.w = cvt_pk_bf16(v1[2], v1[3]);
                    *(u32x4*)(rowp + bj * 128) = w; } }
    }
};
struct EpiKV {
    static constexpr bool RESCALE = false, PERM = true;
    bf16_t* O; bf16_t* VT;
    __device__ __forceinline__ void operator()(AccT& acc, const Unit& u, int wr, int wc, int fr, int fq) const {
        int row0 = u.pm * 256 + wr * 64 + fr, cl = wc * 32 + 8 * fq;
        asm volatile("" : "+v"(row0), "+v"(cl));
#pragma unroll
        for (int ai = 0; ai < 2; ++ai)
#pragma unroll
            for (int m = 0; m < 4; ++m) { const int row = row0 + ai * 128 + m * 16;
                { const f32x4 v0 = acc[ai][0][m][0], v1 = acc[ai][0][m][1];
                  u32x4 w; w.x = cvt_pk_bf16(v0[0], v0[1]); w.y = cvt_pk_bf16(v0[2], v0[3]); w.z = cvt_pk_bf16(v1[0], v1[1]); w.w = cvt_pk_bf16(v1[2], v1[3]);
                  *(u32x4*)(O + (size_t)row * 1024 + u.pn * 256 + cl) = w; }
#pragma unroll
                for (int n = 0; n < 2; ++n) { const f32x4 v = acc[ai][1][m][n];
                    const unsigned w0 = cvt_pk_bf16(v[0], v[1]), w1 = cvt_pk_bf16(v[2], v[3]);
                    bf16_t* vp = VT + (size_t)(u.pn * 128 + cl + n * 4) * SEQ + row;
                    vp[0] = (bf16_t)(w0 & 0xffffu); vp[SEQ] = (bf16_t)(w0 >> 16); vp[2 * SEQ] = (bf16_t)(w1 & 0xffffu); vp[3 * SEQ] = (bf16_t)(w1 >> 16); } }
    }
};
struct EpiGlu {
    static constexpr bool RESCALE = false, PERM = true;
    const bf16_t* yd; const bf16_t* proj; const float* gb; bf16_t* ys;
    __device__ __forceinline__ void operator()(AccT& acc, const Unit& u, int wr, int wc, int fr, int fq) const {
        int row0 = u.pm * 256 + wr * 64 + fr, col0 = u.pn * 256 + wc * 32 + 8 * fq;
        asm volatile("" : "+v"(row0), "+v"(col0));
#pragma unroll
        for (int ai = 0; ai < 2; ++ai)
#pragma unroll
            for (int m = 0; m < 4; ++m) { const size_t row = (size_t)(row0 + ai * 128 + m * 16);
#pragma unroll
                for (int bj = 0; bj < 2; ++bj) { const int c = col0 + bj * 128;
                    float y8[8], z8[8], o8[8]; ld8(yd + row * 512 + c, y8); ld8(proj + row * NP + O_DZ + c, z8);
                    const f32x4 b0 = *(const f32x4*)(gb + c), b1 = *(const f32x4*)(gb + c + 4);
#pragma unroll
                    for (int e = 0; e < 4; ++e) { o8[e] = y8[e] * sigmoidf_(acc[ai][bj][m][0][e] + b0[e]) * siluf_(z8[e]); o8[4 + e] = y8[4 + e] * sigmoidf_(acc[ai][bj][m][1][e] + b1[e]) * siluf_(z8[4 + e]); }
                    st8(ys + row * DM + 1536 + c, o8); } }
    }
};
struct EpiUp {
    static constexpr bool RESCALE = true, PERM = true;
    const bf16_t* proj; bf16_t* O;
    __device__ __forceinline__ void rescale(AccT& acc, const Unit& u, int k, int wr, int wc, int fr, int fq) const {
        int row0 = u.pm * 256 + wr * 64 + fr, col0 = u.pn * 256 + wc * 32 + 8 * fq;
        asm volatile("" : "+v"(row0), "+v"(col0));
#pragma unroll
        for (int ai = 0; ai < 2; ++ai)
#pragma unroll
            for (int m = 0; m < 4; ++m) { const bf16_t* gp = proj + (size_t)(row0 + ai * 128 + m * 16) * NP + GATE0 + (k - 1) * DM + col0;
#pragma unroll
                for (int bj = 0; bj < 2; ++bj) { float ga[8], gb[8]; ld8(gp + bj * 128, ga); ld8(gp + DM + bj * 128, gb);
                    f32x4 r0, r1;
#pragma unroll
                    for (int e = 0; e < 4; ++e) { r0[e] = ga[e] * __builtin_amdgcn_rcpf(fmaxf(gb[e], 1e-30f)); r1[e] = ga[4 + e] * __builtin_amdgcn_rcpf(fmaxf(gb[4 + e], 1e-30f)); }
                    acc[ai][bj][m][0] = acc[ai][bj][m][0] * r0; acc[ai][bj][m][1] = acc[ai][bj][m][1] * r1; }
                asm volatile("" ::: "memory"); }
    }
    __device__ __forceinline__ void operator()(AccT& acc, const Unit& u, int wr, int wc, int fr, int fq) const {
        int row0 = u.pm * 256 + wr * 64 + fr, col0 = u.pn * 256 + wc * 32 + 8 * fq;
        asm volatile("" : "+v"(row0), "+v"(col0));
#pragma unroll
        for (int ai = 0; ai < 2; ++ai)
#pragma unroll
            for (int m = 0; m < 4; ++m) { const size_t row = (size_t)(row0 + ai * 128 + m * 16); const bf16_t* gp = proj + row * NP + GATE0 + 3 * DM + col0;
#pragma unroll
                for (int bj = 0; bj < 2; ++bj) { float g8[8], o8[8]; ld8(gp + bj * 128, g8);
#pragma unroll
                    for (int e = 0; e < 4; ++e) { o8[e] = acc[ai][bj][m][0][e] * g8[e]; o8[4 + e] = acc[ai][bj][m][1][e] * g8[4 + e]; }
                    st8(O + row * DM + col0 + bj * 128, o8); }
                asm volatile("" ::: "memory"); }
    }
};
struct EpiOut {
    static constexpr bool RESCALE = false, PERM = true;
    const float* xin; float* out;
    __device__ __forceinline__ void operator()(AccT& acc, const Unit& u, int wr, int wc, int fr, int fq) const {
        int row0 = u.pm * 256 + wr * 64 + fr, col0 = u.pn * 256 + wc * 32 + 8 * fq;
        asm volatile("" : "+v"(row0), "+v"(col0));
#pragma unroll
        for (int ai = 0; ai < 2; ++ai)
#pragma unroll
            for (int m = 0; m < 4; ++m) { const size_t off = (size_t)(row0 + ai * 128 + m * 16) * DM + col0;
#pragma unroll
                for (int bj = 0; bj < 2; ++bj) { const f32x4 x0 = *(const f32x4*)(xin + off + bj * 128), x1 = *(const f32x4*)(xin + off + bj * 128 + 4);
                    *(f32x4*)(out + off + bj * 128) = x0 + acc[ai][bj][m][0]; *(f32x4*)(out + off + bj * 128 + 4) = x1 + acc[ai][bj][m][1]; } }
    }
};

__device__ __forceinline__ void tr_item(const float* W, int K, int N, bf16_t* WT, int ldk, int split, int shift, LAS float* scr, int item, int lane) {
    const int nblk = (N + 63) >> 6, kb = item / nblk, nb = item - kb * nblk, k0 = 64 * kb, n0 = 64 * nb;
    const int c4 = (lane & 15) * 4, rq = lane >> 4;
    const bool okc = n0 + c4 < N;
    f32x4 tv[16];
#pragma unroll
    for (int i = 0; i < 16; ++i) { const int kk = i * 4 + rq; tv[i] = okc ? *(const f32x4*)(W + (size_t)(k0 + kk) * N + n0 + c4) : (f32x4){0.f, 0.f, 0.f, 0.f}; }
#pragma unroll
    for (int i = 0; i < 16; ++i) { const int kk = i * 4 + rq; LAS float* d = scr + kk * 65 + c4; d[0] = tv[i][0]; d[1] = tv[i][1]; d[2] = tv[i][2]; d[3] = tv[i][3]; }
    LDS_FENCE();
    const int c = lane & 7;
#pragma unroll
    for (int j = 0; j < 8; ++j) { const int n = (lane >> 3) + 8 * j, ng = n0 + n;
        if (ng < N) { const LAS float* sp = scr + (8 * c) * 65 + n;
            u32x4 o; o.x = cvt_pk_bf16(sp[0], sp[65]); o.y = cvt_pk_bf16(sp[130], sp[195]); o.z = cvt_pk_bf16(sp[260], sp[325]); o.w = cvt_pk_bf16(sp[390], sp[455]);
            const int dr = ng < split ? ng : ng + shift;
            *(u32x4*)(WT + (size_t)dr * ldk + k0 + 8 * c) = o; } }
    LDS_FENCE();
}
__device__ __forceinline__ void tr_matrix(const float* W, int K, int N, bf16_t* WT, int ldk, int split, int shift, LAS float* scr, int gw, int ngw, int lane) {
    const int nitems = (K >> 6) * ((N + 63) >> 6);
    for (int it = gw; it < nitems; it += ngw) tr_item(W, K, N, WT, ldk, split, shift, scr, it, lane);
}
__device__ __forceinline__ void phase_weights(KP P, LAS unsigned char* lds) {
    const int tid = fresh_tid(), wave = tid >> 6, lane = tid & 63;
    const int gw = blockIdx.x * 8 + wave, ngw = gridDim.x * 8;
    LAS float* scr = (LAS float*)(lds + wave * 16896);
    for (int l = 0; l < DEPTH; ++l) {
        tr_matrix(P->in[3] + (size_t)l * DM * NIN, DM, NIN, (bf16_t*)(P->ws + W_WIN + l * SZ_WIN), DM, NG0, GATE0 - NG0, scr, gw, ngw, lane);
        tr_matrix(P->in[26] + (size_t)l * DM * DM, DM, DM, (bf16_t*)(P->ws + W_WUP + l * SZ_WSQ), DM, 1 << 30, 0, scr, gw, ngw, lane);
        tr_matrix(P->in[28] + (size_t)l * DM * DM, DM, DM, (bf16_t*)(P->ws + W_WOUT + l * SZ_WSQ), DM, 1 << 30, 0, scr, gw, ngw, lane);
        tr_matrix(P->in[8] + (size_t)l * 448 * 768, 448, 768, (bf16_t*)(P->ws + W_WUQ + l * SZ_WUQ), 512, 1 << 30, 0, scr, gw, ngw, lane);
        tr_matrix(P->in[9] + (size_t)l * 128 * 1024, 128, 1024, (bf16_t*)(P->ws + W_WUKV + l * SZ_WUKV), 256, 1 << 30, 0, scr, gw, ngw, lane);
        tr_matrix(P->in[24] + (size_t)l * 512 * 512, 512, 512, (bf16_t*)(P->ws + W_WGLU + l * SZ_WGLU), 512, 1 << 30, 0, scr, gw, ngw, lane);
    }
    const int gt = blockIdx.x * 512 + tid, ngt = gridDim.x * 512;
    const u32x4 z = {0u, 0u, 0u, 0u};
    for (int l = 0; l < DEPTH; ++l) {
        bf16_t* w = (bf16_t*)(P->ws + W_WIN + l * SZ_WIN) + (size_t)NG0 * DM;
        for (int i = gt; i < (GATE0 - NG0) * DM / 8; i += ngt) *(u32x4*)(w + (size_t)i * 8) = z;
        bf16_t* q = (bf16_t*)(P->ws + W_WUQ + l * SZ_WUQ);
        for (int i = gt; i < 768 * 8; i += ngt) *(u32x4*)(q + (size_t)(i >> 3) * 512 + 448 + (i & 7) * 8) = z;
        bf16_t* kv = (bf16_t*)(P->ws + W_WUKV + l * SZ_WUKV);
        for (int i = gt; i < 1024 * 16; i += ngt) *(u32x4*)(kv + (size_t)(i >> 4) * 256 + 128 + (i & 15) * 8) = z;
    }
}

__device__ __forceinline__ void phase_norm(const float* x, const float* g, bf16_t* h) {
    const int tid = fresh_tid(), wave = tid >> 6, lane = tid & 63;
    for (int row = blockIdx.x * 8 + wave; row < SEQ; row += gridDim.x * 8) {
        const f32x4* xr = (const f32x4*)(x + (size_t)row * DM) + lane;
        f32x4 v[8]; float ss = 0.f;
#pragma unroll
        for (int j = 0; j < 8; ++j) { v[j] = xr[64 * j]; ss += v[j][0] * v[j][0] + v[j][1] * v[j][1] + v[j][2] * v[j][2] + v[j][3] * v[j][3]; }
        const float rstd = rsqrtf(wave_sum(ss) * (1.f / DM) + EPS);
        u32x2* o = (u32x2*)(h + (size_t)row * DM) + lane;
#pragma unroll
        for (int j = 0; j < 8; ++j) { const f32x4 gg = *((const f32x4*)g + lane + 64 * j);
            u32x2 w; w.x = cvt_pk_bf16(v[j][0] * rstd * gg[0], v[j][1] * rstd * gg[1]); w.y = cvt_pk_bf16(v[j][2] * rstd * gg[2], v[j][3] * rstd * gg[3]); o[64 * j] = w; }
    }
}

__device__ __forceinline__ void a_prep_item(KP P, int l, int item, int lane, LAS unsigned char* ldsw) {
    const bf16_t* proj = (const bf16_t*)(P->ws + W_PROJ);
    const int hh = item >> 7, tile = item & 127, g = hh >> 2, dsh = 2 * g, L = SEQ >> dsh;
    const int tq = lane >> 4, ch = lane & 15;
    float gq[8], gk[8];
#pragma unroll
    for (int e = 0; e < 8; ++e) { gq[e] = P->in[4][l * 128 + ch * 8 + e] * (0.08838834764831845f * 1.4426950408889634f); gk[e] = P->in[5][l * 128 + ch * 8 + e]; }
    bf16_t* qd = (bf16_t*)(P->ws + W_QA) + ((size_t)hh * SEQ + tile * 64) * 128 + ch * 8;
    bf16_t* kd = (bf16_t*)(P->ws + W_KA) + ((size_t)hh * SEQ + tile * 64) * 128 + ch * 8;
#pragma unroll 4
    for (int i = 0; i < 16; ++i) {
        const int tok = i * 4 + tq, sp = tile * 64 + tok, r = sp / L, m = sp - r * L, sidx = (m << dsh) + r;
        const bf16_t* src = proj + (size_t)sidx * NP + hh * 128 + ch * 8;
        float a[8], b[8]; ld8(src + O_AQ, a); ld8(src + O_AK, b);
        const u32x4 vv = *(const u32x4*)(src + O_AV);
        float ssq = 0.f, ssk = 0.f;
#pragma unroll
        for (int e = 0; e < 8; ++e) { ssq += a[e] * a[e]; ssk += b[e] * b[e]; }
        ssq += __shfl_xor(ssq, 1); ssk += __shfl_xor(ssk, 1); ssq += __shfl_xor(ssq, 2); ssk += __shfl_xor(ssk, 2);
        ssq += __shfl_xor(ssq, 4); ssk += __shfl_xor(ssk, 4); ssq += __shfl_xor(ssq, 8); ssk += __shfl_xor(ssk, 8);
        const float rq = rsqrtf(ssq * (1.f / 128) + EPS), rk = rsqrtf(ssk * (1.f / 128) + EPS);
#pragma unroll
        for (int e = 0; e < 8; ++e) { a[e] *= rq * gq[e]; b[e] *= rk * gk[e]; }
        st8(qd + (size_t)tok * 128, a); st8(kd + (size_t)tok * 128, b);
        *(LAS u32x4*)(ldsw + tok * 256 + ((ch ^ (tok >> 3)) << 4)) = vv;
    }
    LDS_FENCE();
    bf16_t* vd = (bf16_t*)(P->ws + W_VAT) + (size_t)hh * 128 * SEQ + tile * 64;
    const int c8 = lane & 7;
#pragma unroll 2
    for (int j = 0; j < 16; ++j) { const int dv = j * 8 + (lane >> 3);
        const LAS bf16_t* tp = (const LAS bf16_t*)ldsw + (c8 * 8) * 128 + (dv ^ (c8 << 3));
        u32x4 o; o.x = (unsigned)tp[0] | ((unsigned)tp[128] << 16); o.y = (unsigned)tp[256] | ((unsigned)tp[384] << 16);
        o.z = (unsigned)tp[512] | ((unsigned)tp[640] << 16); o.w = (unsigned)tp[768] | ((unsigned)tp[896] << 16);
        *(u32x4*)(vd + (size_t)dv * SEQ + c8 * 8) = o; }
    LDS_FENCE();
}
__device__ __forceinline__ void b_prep1_cq(KP P, int l, int s_, int lane) {
    const bf16_t* proj = (const bf16_t*)(P->ws + W_PROJ);
    float a[8];
#pragma unroll
    for (int e = 0; e < 8; ++e) a[e] = 0.f;
    if (lane < 56) ld8(proj + (size_t)s_ * NP + O_BCQ + lane * 8, a);
    float ss = 0.f;
#pragma unroll
    for (int e = 0; e < 8; ++e) ss += a[e] * a[e];
    const float rs = rsqrtf(wave_sum(ss) * (1.f / 448) + EPS);
    if (lane < 56) {
#pragma unroll
        for (int e = 0; e < 8; ++e) a[e] *= rs * P->in[6][l * 448 + lane * 8 + e]; }
    st8((bf16_t*)(P->ws + W_CQN) + (size_t)s_ * 512 + lane * 8, a);
}
__device__ __forceinline__ void b_prep1_ckv(KP P, int l, int item, int lane) {
    const bf16_t* proj = (const bf16_t*)(P->ws + W_PROJ);
    const int s_ = item * 4 + (lane >> 4), ch = lane & 15;
    float a[8]; ld8(proj + (size_t)s_ * NP + O_BCKV + ch * 8, a);
    float ss = 0.f;
#pragma unroll
    for (int e = 0; e < 8; ++e) ss += a[e] * a[e];
    ss += __shfl_xor(ss, 1); ss += __shfl_xor(ss, 2); ss += __shfl_xor(ss, 4); ss += __shfl_xor(ss, 8);
    const float rs = rsqrtf(ss * (1.f / 128) + EPS);
#pragma unroll
    for (int e = 0; e < 8; ++e) a[e] *= rs * P->in[7][l * 128 + ch * 8 + e];
    bf16_t* dst = (bf16_t*)(P->ws + W_CKVN) + (size_t)s_ * 256 + ch * 8;
    st8(dst, a);
    unsigned zz = 0u; asm volatile("" : "+v"(zz)); const u32x4 z = {zz, zz, zz, zz}; *(u32x4*)(dst + 128) = z;
}

__device__ __forceinline__ float log_sigmoidf_(float x) { return fminf(x, 0.f) - __logf(1.f + __expf(-fabsf(x))); }
__device__ __forceinline__ void conv8(const bf16_t* proj, const float* cw, const float* cb, int ts, int ch, float sc, float (&o)[8]) {
    float acc[8];
#pragma unroll
    for (int e = 0; e < 8; ++e) acc[e] = cb[ch + e];
#pragma unroll
    for (int j = 0; j < 4; ++j) { const int t = ts - 3 + j;
        if (t >= 0) { float a[8]; ld8(proj + (size_t)t * NP + O_CQK + ch, a);
#pragma unroll
            for (int e = 0; e < 8; ++e) acc[e] += a[e] * cw[j * 512 + ch + e]; } }
#pragma unroll
    for (int e = 0; e < 8; ++e) o[e] = siluf_(acc[e]) * sc;
}
__device__ __forceinline__ void c1_item(KP P, int l, int item, LAS unsigned char* lds) {
    const bf16_t* proj = (const bf16_t*)(P->ws + W_PROJ);
    const int tid = fresh_tid(), lane = tid & 63, wave = tid >> 6, c = item >> 2, h = item & 3, t0 = c * 64, fr = lane & 15, fq = lane >> 4;
    LAS float* wl = (LAS float*)lds;
    LAS bf16_t* VT = (LAS bf16_t*)(lds + 256);
    LAS bf16_t* KWT = VT + 128 * 72;
    const float* cw = P->in[12] + l * 2048; const float* cb = P->in[13] + l * 512;
    if (tid < 64) {
        const bf16_t* row = proj + (size_t)(t0 + lane) * NP;
        const float lf = log_sigmoidf_(bf2f(row[O_CF + h]) + P->in[15][l * 4 + h]);
        const float ig = bf2f(row[O_CI + h]) + P->in[14][l * 4 + h];
        float b = lf;
#pragma unroll
        for (int o = 1; o < 64; o <<= 1) { const float t = __shfl_up(b, o); if (lane >= o) b += t; }
        const float bL = __shfl(b, 63);
        const float gs = bL - b + ig;
        const float mloc = wave_max(gs);
        wl[lane] = __expf(gs - mloc);
        if (lane == 0) { float* meta = (float*)(P->ws + W_META) + item * 2; meta[0] = bL; meta[1] = mloc; }
    }
    __syncthreads();
    { const int s_ = tid >> 3, dg = tid & 7; float k8[8]; conv8(proj, cw, cb, t0 + s_, 256 + h * 64 + dg * 8, 0.125f, k8);
      const float w = wl[s_];
#pragma unroll
      for (int e = 0; e < 8; ++e) KWT[(dg * 8 + e) * 72 + s_] = f2bf(k8[e] * w); }
#pragma unroll
    for (int i = 0; i < 2; ++i) { const int id = tid + i * 512, s_ = id >> 4, cg8 = id & 15;
        const u32x4 vv = *(const u32x4*)(proj + (size_t)(t0 + s_) * NP + O_CV + h * 128 + cg8 * 8);
        LAS bf16_t* vp = VT + (cg8 * 8) * 72 + s_;
        vp[0] = (bf16_t)(vv.x & 0xffffu); vp[72] = (bf16_t)(vv.x >> 16); vp[144] = (bf16_t)(vv.y & 0xffffu); vp[216] = (bf16_t)(vv.y >> 16);
        vp[288] = (bf16_t)(vv.z & 0xffffu); vp[360] = (bf16_t)(vv.z >> 16); vp[432] = (bf16_t)(vv.w & 0xffffu); vp[504] = (bf16_t)(vv.w >> 16); }
    __syncthreads();
    { const int dsub = wave & 3;
#pragma unroll
      for (int vv = 0; vv < 4; ++vv) { const int vs = (wave >> 2) * 4 + vv; f32x4 acc = {0.f, 0.f, 0.f, 0.f};
#pragma unroll
          for (int ks = 0; ks < 2; ++ks) { const bf16x8 a = *(const LAS bf16x8*)(KWT + (dsub * 16 + fr) * 72 + ks * 32 + fq * 8), b = *(const LAS bf16x8*)(VT + (vs * 16 + fr) * 72 + ks * 32 + fq * 8);
              acc = __builtin_amdgcn_mfma_f32_16x16x32_bf16(a, b, acc, 0, 0, 0); }
          *(f32x4*)((float*)(P->ws + W_CLOC) + ((size_t)item * 128 + vs * 16 + fr) * 64 + dsub * 16 + fq * 4) = acc; } }
    if (tid < 64) { float nl = 0.f; for (int s_ = 0; s_ < 64; ++s_) nl += bf2f(KWT[tid * 72 + s_]); ((float*)(P->ws + W_NLOC))[item * 64 + tid] = nl; }
    __syncthreads();
}
__device__ __forceinline__ void c2_multi(KP P, int e0, int estride, const LAS float* metaL) {
    const float* locp[3]; float* stp[3]; int hh[3]; bool isn[3], ok[3]; size_t strd[3];
    float* mst = (float*)(P->ws + W_MST);
#pragma unroll
    for (int k = 0; k < 3; ++k) { const int e = e0 + k * estride; ok[k] = e < 33024; const int ec = ok[k] ? e : 0;
        isn[k] = ec >= 32768; const int ee = isn[k] ? ec - 32768 : ec;
        hh[k] = isn[k] ? ee >> 6 : ee >> 13; const int idx = isn[k] ? ee & 63 : ee & 8191; strd[k] = isn[k] ? 64 : 8192;
        locp[k] = (isn[k] ? (const float*)(P->ws + W_NLOC) : (const float*)(P->ws + W_CLOC)) + idx;
        stp[k] = (isn[k] ? (float*)(P->ws + W_NST) : (float*)(P->ws + W_CST)) + idx;
        isn[k] = isn[k] && idx == 0 && ok[k]; }
    float m[3] = {0.f, 0.f, 0.f}, val[3] = {0.f, 0.f, 0.f};
#pragma unroll 1
    for (int c0 = 0; c0 < 128; c0 += 16) {
        float lv[3][16];
#pragma unroll
        for (int k = 0; k < 3; ++k)
#pragma unroll
            for (int i = 0; i < 16; ++i) lv[k][i] = ok[k] ? locp[k][(size_t)((c0 + i) * 4 + hh[k]) * strd[k]] : 0.f;
#pragma unroll
        for (int i = 0; i < 16; ++i)
#pragma unroll
            for (int k = 0; k < 3; ++k) { const int it = (c0 + i) * 4 + hh[k]; const float bl = metaL[it * 2], ml = metaL[it * 2 + 1];
                if (ok[k]) stp[k][(size_t)it * strd[k]] = val[k];
                if (isn[k]) mst[it] = m[k];
                const float mn = fmaxf(bl + m[k], ml);
                val[k] = __expf(bl + m[k] - mn) * val[k] + __expf(ml - mn) * lv[k][i]; m[k] = mn; }
    }
}
__device__ __forceinline__ void c3_item(KP P, int l, int item, LAS unsigned char* lds) {
    const bf16_t* proj = (const bf16_t*)(P->ws + W_PROJ);
    const int tid = fresh_tid(), lane = tid & 63, wave = tid >> 6, c = item >> 2, h = item & 3, t0 = c * 64, fr = lane & 15, fq = lane >> 4;
    LAS float* bb = (LAS float*)lds;
    LAS float* gi = bb + 64;
    LAS float* mtl = gi + 64;
    LAS float* wil = mtl + 64;
    LAS float* nnl = wil + 64;
    LAS float* nql = nnl + 64;
    LAS float* rsl = nql + 64;
    LAS bf16_t* Qs = (LAS bf16_t*)(lds + 2048);
    LAS bf16_t* Ks = Qs + 64 * 72;
    LAS bf16_t* SQ = Ks + 64 * 72;
    LAS bf16_t* VT = SQ + 64 * 72;
    LAS bf16_t* Cs = VT + 128 * 72;
    const float* cw = P->in[12] + l * 2048; const float* cb = P->in[13] + l * 512;
    const float m_in = ((const float*)(P->ws + W_MST))[item];
    if (tid < 64) {
        const bf16_t* row = proj + (size_t)(t0 + lane) * NP;
        const float lf = log_sigmoidf_(bf2f(row[O_CF + h]) + P->in[15][l * 4 + h]);
        const float ig = bf2f(row[O_CI + h]) + P->in[14][l * 4 + h];
        float b = lf;
#pragma unroll
        for (int o = 1; o < 64; o <<= 1) { const float t = __shfl_up(b, o); if (lane >= o) b += t; }
        const float d = ig - b; float pm = d;
#pragma unroll
        for (int o = 1; o < 64; o <<= 1) { const float t = __shfl_up(pm, o); if (lane >= o) pm = fmaxf(pm, t); }
        const float mt = b + fmaxf(m_in, pm);
        bb[lane] = b; gi[lane] = d; mtl[lane] = mt; wil[lane] = __expf(b + m_in - mt);
        nnl[lane] = ((const float*)(P->ws + W_NST))[item * 64 + lane];
    }
    { const int s_ = tid >> 3, dg = tid & 7; float a[8]; u32x4 w;
      conv8(proj, cw, cb, t0 + s_, h * 64 + dg * 8, 1.f, a);
      w.x = cvt_pk_bf16(a[0], a[1]); w.y = cvt_pk_bf16(a[2], a[3]); w.z = cvt_pk_bf16(a[4], a[5]); w.w = cvt_pk_bf16(a[6], a[7]);
      *(LAS u32x4*)(Qs + s_ * 72 + dg * 8) = w;
      conv8(proj, cw, cb, t0 + s_, 256 + h * 64 + dg * 8, 0.125f, a);
      w.x = cvt_pk_bf16(a[0], a[1]); w.y = cvt_pk_bf16(a[2], a[3]); w.z = cvt_pk_bf16(a[4], a[5]); w.w = cvt_pk_bf16(a[6], a[7]);
      *(LAS u32x4*)(Ks + s_ * 72 + dg * 8) = w; }
#pragma unroll
    for (int i = 0; i < 2; ++i) { const int id = tid + i * 512, s_ = id >> 4, cg8 = id & 15;
        const u32x4 vv = *(const u32x4*)(proj + (size_t)(t0 + s_) * NP + O_CV + h * 128 + cg8 * 8);
        LAS bf16_t* vp = VT + (cg8 * 8) * 72 + s_;
        vp[0] = (bf16_t)(vv.x & 0xffffu); vp[72] = (bf16_t)(vv.x >> 16); vp[144] = (bf16_t)(vv.y & 0xffffu); vp[216] = (bf16_t)(vv.y >> 16);
        vp[288] = (bf16_t)(vv.z & 0xffffu); vp[360] = (bf16_t)(vv.z >> 16); vp[432] = (bf16_t)(vv.w & 0xffffu); vp[504] = (bf16_t)(vv.w >> 16); }
    { const float* cst = (const float*)(P->ws + W_CST) + (size_t)item * 8192;
#pragma unroll
      for (int i = 0; i < 4; ++i) { const int id = tid + i * 512, v = id >> 4, d4 = (id & 15) * 4; const f32x4 x = *(const f32x4*)(cst + v * 64 + d4);
          u32x2 w; w.x = cvt_pk_bf16(x[0], x[1]); w.y = cvt_pk_bf16(x[2], x[3]); *(LAS u32x2*)(Cs + v * 72 + d4) = w; } }
    __syncthreads();
    { const int tsub = wave >> 1; float rsum[4] = {0.f, 0.f, 0.f, 0.f};
#pragma unroll
      for (int q2 = 0; q2 < 2; ++q2) { const int ssub = (wave & 1) * 2 + q2; f32x4 acc = {0.f, 0.f, 0.f, 0.f};
#pragma unroll
          for (int ks = 0; ks < 2; ++ks) { const bf16x8 a = *(const LAS bf16x8*)(Qs + (tsub * 16 + fr) * 72 + ks * 32 + fq * 8), b = *(const LAS bf16x8*)(Ks + (ssub * 16 + fr) * 72 + ks * 32 + fq * 8);
              acc = __builtin_amdgcn_mfma_f32_16x16x32_bf16(a, b, acc, 0, 0, 0); }
          const int ss = ssub * 16 + fr; const float gs = gi[ss];
#pragma unroll
          for (int j = 0; j < 4; ++j) { const int tt = tsub * 16 + fq * 4 + j;
              const float val = (ss <= tt) ? __expf(bb[tt] + gs - mtl[tt]) * acc[j] : 0.f;
              SQ[tt * 72 + ss] = f2bf(val); rsum[j] += val; } }
#pragma unroll
      for (int j = 0; j < 4; ++j) { const float r = row16_sum(rsum[j]); if (fr == 0) rsl[(tsub * 16 + fq * 4 + j) * 2 + (wave & 1)] = r; } }
    { const int t = tid >> 3, part = tid & 7; float a[8]; const u32x4 u = *(const LAS u32x4*)(Qs + t * 72 + part * 8);
      a[0] = bflo(u.x); a[1] = bfhi(u.x); a[2] = bflo(u.y); a[3] = bfhi(u.y); a[4] = bflo(u.z); a[5] = bfhi(u.z); a[6] = bflo(u.w); a[7] = bfhi(u.w);
      float p = 0.f;
#pragma unroll
      for (int e = 0; e < 8; ++e) p += a[e] * nnl[part * 8 + e];
      p += __shfl_xor(p, 1); p += __shfl_xor(p, 2); p += __shfl_xor(p, 4);
      if (part == 0) nql[t] = p; }
    __syncthreads();
    { const int tsub = wave >> 1, t = tsub * 16 + fr;
      const float wi = wil[t], den = wi * nql[t] + rsl[t * 2] + rsl[t * 2 + 1];
      const float inv = 1.f / fmaxf(fabsf(den), __expf(-mtl[t]));
      bf16x8 qb[2], sb[2];
#pragma unroll
      for (int ks = 0; ks < 2; ++ks) { qb[ks] = *(const LAS bf16x8*)(Qs + t * 72 + ks * 32 + fq * 8); sb[ks] = *(const LAS bf16x8*)(SQ + t * 72 + ks * 32 + fq * 8); }
#pragma unroll
      for (int vv = 0; vv < 4; ++vv) { const int vs = (wave & 1) * 4 + vv; f32x4 inter = {0.f, 0.f, 0.f, 0.f}, intra = {0.f, 0.f, 0.f, 0.f};
#pragma unroll
          for (int ks = 0; ks < 2; ++ks) { const bf16x8 ca = *(const LAS bf16x8*)(Cs + (vs * 16 + fr) * 72 + ks * 32 + fq * 8), va = *(const LAS bf16x8*)(VT + (vs * 16 + fr) * 72 + ks * 32 + fq * 8);
              inter = __builtin_amdgcn_mfma_f32_16x16x32_bf16(ca, qb[ks], inter, 0, 0, 0);
              intra = __builtin_amdgcn_mfma_f32_16x16x32_bf16(va, sb[ks], intra, 0, 0, 0); }
          const int v0 = vs * 16 + fq * 4;
          const bf16_t* prow = proj + (size_t)(t0 + t) * NP + h * 128 + v0;
          const u32x2 op = *(const u32x2*)(prow + O_CO), zz = *(const u32x2*)(prow + O_CZ);
          const float o0 = sigmoidf_(bflo(op.x)) * (wi * inter[0] + intra[0]) * inv * siluf_(bflo(zz.x));
          const float o1 = sigmoidf_(bfhi(op.x)) * (wi * inter[1] + intra[1]) * inv * siluf_(bfhi(zz.x));
          const float o2 = sigmoidf_(bflo(op.y)) * (wi * inter[2] + intra[2]) * inv * siluf_(bflo(zz.y));
          const float o3 = sigmoidf_(bfhi(op.y)) * (wi * inter[3] + intra[3]) * inv * siluf_(bfhi(zz.y));
          u32x2 w; w.x = cvt_pk_bf16(o0, o1); w.y = cvt_pk_bf16(o2, o3);
          *(u32x2*)((bf16_t*)(P->ws + W_YS) + (size_t)(t0 + t) * DM + 1024 + h * 128 + v0) = w; } }
    __syncthreads();
}

struct S5Lane { float are, aim, bre[16], bim[16]; };
__device__ __forceinline__ void s5_setup(KP P, int l, int g, int p, S5Lane& L) {
    const int gp = (l * 32 + g) * 64 + p;
    const float lr = P->in[16][gp], li = P->in[17][gp], dt = expf(P->in[18][l * 32 + g]);
    const float mag = expf(lr * dt); float sn, cs; sincosf(li * dt, &sn, &cs);
    L.are = mag * cs; L.aim = mag * sn;
    const float den = lr * lr + li * li;
    const float fre = ((L.are - 1.f) * lr + L.aim * li) / den, fim = (L.aim * lr - (L.are - 1.f) * li) / den;
    const f32x4* br = (const f32x4*)(P->in[19] + (size_t)gp * 16); const f32x4* bi = (const f32x4*)(P->in[20] + (size_t)gp * 16);
#pragma unroll
    for (int j = 0; j < 4; ++j) { const f32x4 r = br[j], i = bi[j];
#pragma unroll
        for (int e = 0; e < 4; ++e) { L.bre[j * 4 + e] = fre * r[e] - fim * i[e]; L.bim[j * 4 + e] = fre * i[e] + fim * r[e]; } }
}
__device__ __forceinline__ void s5_step(const S5Lane& L, const bf16_t* urow, float& xr, float& xi) {
    float u0[8], u1[8]; ld8(urow, u0); ld8(urow + 8, u1);
    float br = 0.f, bi = 0.f;
#pragma unroll
    for (int e = 0; e < 8; ++e) { br += u0[e] * L.bre[e]; bi += u0[e] * L.bim[e]; }
#pragma unroll
    for (int e = 0; e < 8; ++e) { br += u1[e] * L.bre[8 + e]; bi += u1[e] * L.bim[8 + e]; }
    const float nr = L.are * xr - L.aim * xi + br, ni = L.are * xi + L.aim * xr + bi;
    xr = nr; xi = ni;
}
__device__ __forceinline__ float gelu_tanh(float x) {
    const float u = 0.7978845608028654f * (x + 0.044715f * x * x * x);
    const float e = __expf(2.f * u);
    const float th = 1.f - 2.f * __builtin_amdgcn_rcpf(e + 1.f);
    return 0.5f * x * (1.f + th);
}
__device__ __forceinline__ unsigned pack_bf2(float a, float b) { return cvt_pk_bf16(a, b); }
template <bool OUT>
__device__ __forceinline__ void s5_item(KP P, int l, int item, int lane, LAS unsigned char* ldsw) {
    const bf16_t* proj = (const bf16_t*)(P->ws + W_PROJ);
    const int c = item >> 5, g = item & 31, fr = lane & 15, fq = lane >> 4, lg = l * 32 + g;
    LAS float* buL = (LAS float*)ldsw;
    LAS bf16_t* xL = (LAS bf16_t*)(ldsw + 8448);
    const float dt = expf(P->in[18][lg]);
    float are, aim;
    { const float lr = P->in[16][lg * 64 + lane], li = P->in[17][lg * 64 + lane]; const float mag = expf(lr * dt); float sn, cs; sincosf(li * dt, &sn, &cs); are = mag * cs; aim = mag * sn; }
    bf16x8 bfr[8];
#pragma unroll
    for (int q = 0; q < 4; ++q) {
        u32x4 wr = {0u, 0u, 0u, 0u}, wi = {0u, 0u, 0u, 0u};
        if (fq < 2) {
            const int pp = q * 16 + fr, gp = lg * 64 + pp;
            const float lr = P->in[16][gp], li = P->in[17][gp]; const float mag = expf(lr * dt); float sn, cs; sincosf(li * dt, &sn, &cs);
            const float ar = mag * cs, ai = mag * sn, den = lr * lr + li * li;
            const float fre = ((ar - 1.f) * lr + ai * li) / den, fim = (ai * lr - (ar - 1.f) * li) / den;
            const f32x4 r0 = *(const f32x4*)(P->in[19] + (size_t)gp * 16 + fq * 8), r1 = *(const f32x4*)(P->in[19] + (size_t)gp * 16 + fq * 8 + 4);
            const f32x4 i0 = *(const f32x4*)(P->in[20] + (size_t)gp * 16 + fq * 8), i1 = *(const f32x4*)(P->in[20] + (size_t)gp * 16 + fq * 8 + 4);
            wr.x = pack_bf2(fre * r0[0] - fim * i0[0], fre * r0[1] - fim * i0[1]); wr.y = pack_bf2(fre * r0[2] - fim * i0[2], fre * r0[3] - fim * i0[3]);
            wr.z = pack_bf2(fre * r1[0] - fim * i1[0], fre * r1[1] - fim * i1[1]); wr.w = pack_bf2(fre * r1[2] - fim * i1[2], fre * r1[3] - fim * i1[3]);
            wi.x = pack_bf2(fre * i0[0] + fim * r0[0], fre * i0[1] + fim * r0[1]); wi.y = pack_bf2(fre * i0[2] + fim * r0[2], fre * i0[3] + fim * r0[3]);
            wi.z = pack_bf2(fre * i1[0] + fim * r1[0], fre * i1[1] + fim * r1[1]); wi.w = pack_bf2(fre * i1[2] + fim * r1[2], fre * i1[3] + fim * r1[3]);
        }
        bfr[q] = __builtin_bit_cast(bf16x8, wr); bfr[4 + q] = __builtin_bit_cast(bf16x8, wi);
    }
    bf16x8 cfr[4]; float dsk = 0.f;
    if (OUT) {
#pragma unroll
        for (int ks = 0; ks < 4; ++ks) { const float* src = (ks < 2 ? P->in[21] : P->in[22]) + ((size_t)lg * 16 + fr) * 64 + (ks & 1) * 32 + fq * 8; const float sg = ks < 2 ? 1.f : -1.f;
            const f32x4 a = *(const f32x4*)src, b = *(const f32x4*)(src + 4);
            u32x4 w; w.x = pack_bf2(sg * a[0], sg * a[1]); w.y = pack_bf2(sg * a[2], sg * a[3]); w.z = pack_bf2(sg * b[0], sg * b[1]); w.w = pack_bf2(sg * b[2], sg * b[3]);
            cfr[ks] = __builtin_bit_cast(bf16x8, w); }
        dsk = P->in[23][l * 512 + g * 16 + fr];
    }
    float xr = 0.f, xi = 0.f;
    if (OUT) { const float* xs = (const float*)(P->ws + W_XST) + ((size_t)c * 2048 + g * 64 + lane) * 2; xr = xs[0]; xi = xs[1]; }
#pragma unroll 1
    for (int sub = 0; sub < 4; ++sub) {
        const int tb = c * 64 + sub * 16;
        u32x4 uw = {0u, 0u, 0u, 0u};
        if (fq < 2) uw = *(const u32x4*)(proj + (size_t)(tb + fr) * NP + O_DU + g * 16 + fq * 8);
        const bf16x8 ua = __builtin_bit_cast(bf16x8, uw);
#pragma unroll
        for (int ns = 0; ns < 8; ++ns) { const f32x4 z = {0.f, 0.f, 0.f, 0.f}; const f32x4 r = __builtin_amdgcn_mfma_f32_16x16x32_bf16(ua, bfr[ns], z, 0, 0, 0);
#pragma unroll
            for (int j = 0; j < 4; ++j) buL[(fq * 4 + j) * 132 + ns * 16 + fr] = r[j]; }
        LDS_FENCE();
#pragma unroll
        for (int t = 0; t < 16; ++t) { const float br = buL[t * 132 + lane], bi = buL[t * 132 + 64 + lane];
            const float nr = are * xr - aim * xi + br, ni = are * xi + aim * xr + bi; xr = nr; xi = ni;
            if (OUT) { xL[t * 136 + lane] = f2bf(xr); xL[t * 136 + 64 + lane] = f2bf(xi); } }
        if (OUT) {
            LDS_FENCE();
            f32x4 y = {0.f, 0.f, 0.f, 0.f};
#pragma unroll
            for (int ks = 0; ks < 4; ++ks) { const bf16x8 af = *(const LAS bf16x8*)(xL + fr * 136 + ks * 32 + fq * 8); y = __builtin_amdgcn_mfma_f32_16x16x32_bf16(af, cfr[ks], y, 0, 0, 0); }
#pragma unroll
            for (int j = 0; j < 4; ++j) { const size_t trow = (size_t)(tb + fq * 4 + j);
                const float uu = bf2f(proj[trow * NP + O_DU + g * 16 + fr]);
                ((bf16_t*)(P->ws + W_YD))[trow * 512 + g * 16 + fr] = f2bf(gelu_tanh(y[j] + dsk * uu)); }
        }
        LDS_FENCE();
    }
    if (!OUT) { float* xe = (float*)(P->ws + W_XEND) + ((size_t)c * 2048 + g * 64 + lane) * 2; xe[0] = xr; xe[1] = xi; }
}
__device__ __forceinline__ void d2_elem(KP P, int l, int e) {
    const int gp = l * 2048 + e;
    const float lr = P->in[16][gp], li = P->in[17][gp], dt = expf(P->in[18][l * 32 + (e >> 6)]);
    const float mag = expf(lr * dt); float sn, cs; sincosf(li * dt, &sn, &cs);
    float ar = mag * cs, ai = mag * sn;
#pragma unroll
    for (int i = 0; i < 6; ++i) { const float r = ar * ar - ai * ai, im = 2.f * ar * ai; ar = r; ai = im; }
    const float* xe = (const float*)(P->ws + W_XEND); float* xs = (float*)(P->ws + W_XST);
    float xr = 0.f, xi = 0.f;
#pragma unroll 1
    for (int c0 = 0; c0 < 128; c0 += 32) {
        float er[32], ei[32];
#pragma unroll
        for (int i = 0; i < 32; ++i) { const size_t o = ((size_t)(c0 + i) * 2048 + e) * 2; er[i] = xe[o]; ei[i] = xe[o + 1]; }
#pragma unroll
        for (int i = 0; i < 32; ++i) { const size_t o = ((size_t)(c0 + i) * 2048 + e) * 2; xs[o] = xr; xs[o + 1] = xi;
            const float nr = ar * xr - ai * xi + er[i], ni = ar * xi + ai * xr + ei[i]; xr = nr; xi = ni; }
    }
}
__device__ __forceinline__ void b_prep2_item(KP P, int l, int s_, int lane) {
    const bf16_t* proj = (const bf16_t*)(P->ws + W_PROJ);
    const int h = lane >> 4, i = lane & 15;
    const bool hasr = i < 8, isx1 = i < 4;
    const float posf = (float)((const int*)P->in[1])[s_];
    float cs[8], sn[8];
#pragma unroll
    for (int e = 0; e < 8; ++e) { const int fi = (i & 3) * 8 + e;
        const float inv = exp2f(-(float)fi * 0.41524101186092029f);
        const float ang = posf * inv;
        const double t = (double)ang * 0.15915494309189535;
        const float fr = (float)(t - __builtin_rint(t));
        sn[e] = __builtin_amdgcn_sinf(fr); cs[e] = __builtin_amdgcn_cosf(fr); }
    const bf16_t* qsrc = (const bf16_t*)(P->ws + W_QRAW) + (size_t)s_ * 768 + h * 192;
    const bf16_t* ksrc = (const bf16_t*)(P->ws + W_KVRAW) + (size_t)s_ * 1024 + h * 256;
    const bf16_t* krsrc = proj + (size_t)s_ * NP + O_BKR;
    bf16_t* qd = (bf16_t*)(P->ws + W_QB) + ((size_t)h * SEQ + s_) * 192;
    bf16_t* kd = (bf16_t*)(P->ws + W_KB) + ((size_t)h * SEQ + s_) * 192;
#pragma unroll
    for (int w = 0; w < 2; ++w) {
        float a[8], ar[8];
#pragma unroll
        for (int e = 0; e < 8; ++e) ar[e] = 0.f;
        ld8((w ? ksrc : qsrc) + i * 8, a);
        if (hasr) ld8(w ? krsrc + i * 8 : qsrc + 128 + i * 8, ar);
        float ss = 0.f;
#pragma unroll
        for (int e = 0; e < 8; ++e) ss += a[e] * a[e] + ar[e] * ar[e];
        ss += __shfl_xor(ss, 1); ss += __shfl_xor(ss, 2); ss += __shfl_xor(ss, 4); ss += __shfl_xor(ss, 8);
        const float rs = rsqrtf(ss * (1.f / 192) + EPS) * (w ? 1.f : 0.07216878364870322f * 1.4426950408889634f);
        const float* gg = (w ? P->in[11] : P->in[10]) + l * 192;
        float o[8];
#pragma unroll
        for (int e = 0; e < 8; ++e) { a[e] *= rs * gg[i * 8 + e]; ar[e] *= rs * gg[128 + (i & 7) * 8 + e]; }
#pragma unroll
        for (int e = 0; e < 8; ++e) { const float pr = __shfl_xor(ar[e], 4);
            o[e] = isx1 ? ar[e] * cs[e] - pr * sn[e] : ar[e] * cs[e] + pr * sn[e]; }
        bf16_t* dd = w ? kd : qd;
        st8(dd + i * 8, a);
        if (hasr) st8(dd + 128 + i * 8, o);
    }
}

template <int DQK>
__device__ __forceinline__ void attn_block(LAS unsigned char* lds, const bf16_t* Qp, const bf16_t* Kp, const bf16_t* VTp, int q_idx0, int kt_lo, int kt_hi,
                                           int maxdelta, float bslope, int dsh, bf16_t* Op, float* Lp, int head) {
    constexpr int KS = DQK + 8, KC = DQK / 8, NKC = 64 * KC / 512, KBYTES = 64 * KS * 2, VBYTES = 128 * 72 * 2;
    const int tid = fresh_tid(), wave = tid >> 6, lane = tid & 63, fr = lane & 15, fq = lane >> 4;
    LAS unsigned char* Kb = lds; LAS unsigned char* Vb = lds + 2 * KBYTES; LAS unsigned char* Pw = lds + 2 * KBYTES + 2 * VBYTES + wave * (16 * 72 * 2);
    bf16x8 qf[DQK / 32];
#pragma unroll
    for (int ks = 0; ks < DQK / 32; ++ks) qf[ks] = *(const bf16x8*)(Qp + (size_t)(wave * 16 + fr) * DQK + ks * 32 + fq * 8);
    f32x4 o[8]; float m_run[4], l_run[4];
#pragma unroll
    for (int i = 0; i < 8; ++i) o[i] = (f32x4){0.f, 0.f, 0.f, 0.f};
#pragma unroll
    for (int j = 0; j < 4; ++j) { m_run[j] = -1e30f; l_run[j] = 0.f; }
    u32x4 kreg[NKC], vreg[2];
#define ATT_LOAD(kt) do { _Pragma("unroll") for (int _i = 0; _i < NKC; ++_i) { const int id = tid + _i * 512, row = id / KC, c8 = id - row * KC; kreg[_i] = *(const u32x4*)(Kp + (size_t)((kt) * 64 + row) * DQK + c8 * 8); } \
        _Pragma("unroll") for (int _i = 0; _i < 2; ++_i) { const int id = tid + _i * 512, row = id >> 3, c8 = id & 7; vreg[_i] = *(const u32x4*)(VTp + (size_t)row * SEQ + (kt) * 64 + c8 * 8); } } while (0)
#define ATT_STORE(buf) do { _Pragma("unroll") for (int _i = 0; _i < NKC; ++_i) { const int id = tid + _i * 512, row = id / KC, c8 = id - row * KC; *(LAS u32x4*)(Kb + (buf) * KBYTES + (row * KS + c8 * 8) * 2) = kreg[_i]; } \
        _Pragma("unroll") for (int _i = 0; _i < 2; ++_i) { const int id = tid + _i * 512, row = id >> 3, c8 = id & 7; *(LAS u32x4*)(Vb + (buf) * VBYTES + (row * 72 + c8 * 8) * 2) = vreg[_i]; } } while (0)
    if (kt_lo < kt_hi) { ATT_LOAD(kt_lo); ATT_STORE(0); }
    __syncthreads();
#pragma unroll
    for (int ks = 0; ks < DQK / 32; ++ks) asm volatile("" : "+v"(qf[ks]));
    auto tile_step = [&](auto masktag, int kt) {
        const int cur = (kt - kt_lo) & 1;
        if (kt + 1 < kt_hi) ATT_LOAD(kt + 1);
        f32x4 s[4];
#pragma unroll
        for (int n = 0; n < 4; ++n) s[n] = (f32x4){0.f, 0.f, 0.f, 0.f};
        { bf16x8 kf[2][4];
          const LAS unsigned char* kbase_p = Kb + cur * KBYTES + (fr * KS + fq * 8) * 2;
#pragma unroll
          for (int n = 0; n < 4; ++n) kf[0][n] = *(const LAS bf16x8*)(kbase_p + (n * 16 * KS) * 2);
#pragma unroll
          for (int ks = 0; ks < DQK / 32; ++ks) {
              if (ks + 1 < DQK / 32) {
#pragma unroll
                  for (int n = 0; n < 4; ++n) kf[(ks + 1) & 1][n] = *(const LAS bf16x8*)(kbase_p + (n * 16 * KS + (ks + 1) * 32) * 2); }
              __builtin_amdgcn_sched_barrier(0);
#pragma unroll
              for (int n = 0; n < 4; ++n) s[n] = __builtin_amdgcn_mfma_f32_16x16x32_bf16(qf[ks], kf[ks & 1][n], s[n], 0, 0, 0);
              __builtin_amdgcn_sched_barrier(0);
          } }
        if constexpr (decltype(masktag)::value) {
        const int kbase = kt * 64 + fr;
#pragma unroll
        for (int j = 0; j < 4; ++j) {
            const int qi = q_idx0 + wave * 16 + fq * 4 + j;
            float tmax = -1e30f;
#pragma unroll
            for (int n = 0; n < 4; ++n) { const int delta = qi - (kbase + n * 16); const bool valid = (unsigned)delta <= (unsigned)maxdelta;
                const float sv = valid ? s[n][j] - bslope * (float)delta : -1e30f; s[n][j] = sv; tmax = fmaxf(tmax, sv); }
            tmax = row16_max(tmax);
            const float mn = fmaxf(m_run[j], tmax), alpha = __builtin_amdgcn_exp2f(m_run[j] - mn);
            m_run[j] = mn;
            float psum = 0.f;
#pragma unroll
            for (int n = 0; n < 4; ++n) { const float p = s[n][j] > -1e29f ? __builtin_amdgcn_exp2f(s[n][j] - mn) : 0.f; psum += p;
                *(LAS bf16_t*)(Pw + ((fq * 4 + j) * 72 + n * 16 + fr) * 2) = f2bf(p); }
            l_run[j] = l_run[j] * alpha + psum;
#pragma unroll
            for (int d = 0; d < 8; ++d) o[d][j] *= alpha;
        }
        } else {
            float mn[4];
#pragma unroll
            for (int j = 0; j < 4; ++j) { float tmax = fmaxf(fmaxf(s[0][j], s[1][j]), fmaxf(s[2][j], s[3][j])); tmax = row16_max(tmax); mn[j] = fmaxf(m_run[j], tmax); }
#pragma unroll
            for (int j = 0; j < 4; ++j) { const float alpha = __builtin_amdgcn_exp2f(m_run[j] - mn[j]); m_run[j] = mn[j];
                float psum = 0.f;
#pragma unroll
                for (int n = 0; n < 4; ++n) { const float p = __builtin_amdgcn_exp2f(s[n][j] - mn[j]); psum += p;
                    *(LAS bf16_t*)(Pw + ((fq * 4 + j) * 72 + n * 16 + fr) * 2) = f2bf(p); }
                l_run[j] = l_run[j] * alpha + psum;
#pragma unroll
                for (int d = 0; d < 8; ++d) o[d][j] *= alpha; }
        }
        LDS_FENCE();
        { bf16x8 pf[2], vf[2][4];
          const LAS unsigned char* vbase_p = Vb + cur * VBYTES + (fr * 72 + fq * 8) * 2;
          pf[0] = *(const LAS bf16x8*)(Pw + (fr * 72 + fq * 8) * 2); pf[1] = *(const LAS bf16x8*)(Pw + (fr * 72 + 32 + fq * 8) * 2);
#pragma unroll
          for (int d4 = 0; d4 < 4; ++d4) vf[0][d4] = *(const LAS bf16x8*)(vbase_p + (d4 * 16 * 72) * 2);
#pragma unroll
          for (int gI = 0; gI < 4; ++gI) {
              if (gI + 1 < 4) {
#pragma unroll
                  for (int d4 = 0; d4 < 4; ++d4) vf[(gI + 1) & 1][d4] = *(const LAS bf16x8*)(vbase_p + ((((gI + 1) & 1) * 4 + d4) * 16 * 72 + ((gI + 1) >> 1) * 32) * 2); }
              __builtin_amdgcn_sched_barrier(0);
#pragma unroll
              for (int d4 = 0; d4 < 4; ++d4) o[(gI & 1) * 4 + d4] = __builtin_amdgcn_mfma_f32_16x16x32_bf16(pf[gI >> 1], vf[gI & 1][d4], o[(gI & 1) * 4 + d4], 0, 0, 0);
              __builtin_amdgcn_sched_barrier(0);
          } }
        if (kt + 1 < kt_hi) ATT_STORE(cur ^ 1);
        __syncthreads();
    };
    { const int kt_int = (maxdelta < (1 << 29)) ? kt_lo : min(kt_hi, max(kt_lo, q_idx0 >> 6));
      for (int kt = kt_lo; kt < kt_int; ++kt) tile_step(std::integral_constant<bool, false>{}, kt);
      for (int kt = kt_int; kt < kt_hi; ++kt) tile_step(std::integral_constant<bool, true>{}, kt); }
#undef ATT_LOAD
#undef ATT_STORE
    const int L = SEQ >> dsh;
#pragma unroll
    for (int j = 0; j < 4; ++j) {
        float lt = l_run[j]; lt += __shfl_xor(lt, 1); lt += __shfl_xor(lt, 2); lt += __shfl_xor(lt, 4); lt += __shfl_xor(lt, 8);
        const float inv = lt > 0.f ? 1.f / lt : 0.f, lse = lt > 0.f ? (m_run[j] + __log2f(lt)) * 0.6931471805599453f : -1e30f;
        const int p = q_idx0 + wave * 16 + fq * 4 + j, r = p / L, m = p - r * L, srow = (m << dsh) + r;
        bf16_t* orow = Op + (size_t)srow * 512 + head * 128 + fr;
#pragma unroll
        for (int d = 0; d < 8; ++d) orow[d * 16] = f2bf(o[d][j] * inv);
        if (fr == 0) Lp[srow * 4 + head] = lse;
    }
}

__device__ __forceinline__ f32x4 ld4bf(const bf16_t* p) { const u32x2 u = *(const u32x2*)p; return (f32x4){bflo(u.x), bfhi(u.x), bflo(u.y), bfhi(u.y)}; }
__device__ __forceinline__ void phase_combine(KP P) {
    const bf16_t* proj = (const bf16_t*)(P->ws + W_PROJ);
    bf16_t* ys = (bf16_t*)(P->ws + W_YS);
    const bf16_t* oA = (const bf16_t*)(P->ws + W_OA); const float* lA = (const float*)(P->ws + W_LSEA);
    const bf16_t* oB = (const bf16_t*)(P->ws + W_OB); const float* lB = (const float*)(P->ws + W_LSEB);
    const int tid = fresh_tid(), skip = gridDim.x > 128 ? 64 : 0;
    if ((int)blockIdx.x < skip) return;
    for (int idx = ((int)blockIdx.x - skip) * 512 + tid; idx < SEQ * 256; idx += ((int)gridDim.x - skip) * 512) {
        const int s = idx >> 8, cg4 = idx & 255, br = cg4 >> 7, c4 = (cg4 & 127) * 4, j = c4 >> 7;
        f32x4 o; u32x2 zz;
        if (br == 0) {
            const float l0 = lA[s * 4 + j], l1 = lA[(SEQ + s) * 4 + j], l2 = lA[(2 * SEQ + s) * 4 + j];
            const float mx = fmaxf(l0, fmaxf(l1, l2)); const float w0 = __expf(l0 - mx), w1 = __expf(l1 - mx), w2 = __expf(l2 - mx); const float inv = 1.f / (w0 + w1 + w2);
            const f32x4 a = ld4bf(oA + (size_t)s * 512 + c4), b = ld4bf(oA + ((size_t)SEQ + s) * 512 + c4), c = ld4bf(oA + ((size_t)2 * SEQ + s) * 512 + c4);
            o = (a * w0 + b * w1 + c * w2) * inv;
            zz = *(const u32x2*)(proj + (size_t)s * NP + O_AZ + c4);
        } else {
            const float l0 = lB[s * 4 + j], l1 = lB[(SEQ + s) * 4 + j];
            const float mx = fmaxf(l0, l1); const float w0 = __expf(l0 - mx), w1 = __expf(l1 - mx); const float inv = 1.f / (w0 + w1);
            const f32x4 a = ld4bf(oB + (size_t)s * 512 + c4), b = ld4bf(oB + ((size_t)SEQ + s) * 512 + c4);
            o = (a * w0 + b * w1) * inv;
            zz = *(const u32x2*)(proj + (size_t)s * NP + O_BZ + c4);
        }
        u32x2 w; w.x = cvt_pk_bf16(o[0] * siluf_(bflo(zz.x)), o[1] * siluf_(bfhi(zz.x))); w.y = cvt_pk_bf16(o[2] * siluf_(bflo(zz.y)), o[3] * siluf_(bfhi(zz.y)));
        *(u32x2*)(ys + (size_t)s * DM + br * 512 + c4) = w;
    }
}

#define XB_TMO      128
#define XB_XCNT(j)  (256  + 64 * (j))
#define XB_XSUB(j)  (1280 + 64 * (j))
#define XB_XGEN(j)  (2304 + 64 * (j))
#define XB_TOP      3328
#define XB_TOPGEN   3392
#define XCD_BAR_WORDS 3456
#define XB_SPIN_CAP (1u << 20)
__device__ __forceinline__ unsigned xb_ld(unsigned* p)              { return __hip_atomic_load(p, __ATOMIC_RELAXED, __HIP_MEMORY_SCOPE_AGENT); }
__device__ __forceinline__ unsigned xb_add(unsigned* p, unsigned v) { return __hip_atomic_fetch_add(p, v, __ATOMIC_RELAXED, __HIP_MEMORY_SCOPE_AGENT); }
__device__ __forceinline__ unsigned xb_xcc_id() { return (unsigned)__builtin_amdgcn_s_getreg((3 << 11) | 20) & 0xFu; }
#define XB_SPIN(cond, bar) do { unsigned _sp = 0; while (cond) { __builtin_amdgcn_s_sleep(0); \
    if ((++_sp & 255u) == 0u) { if (xb_ld(&(bar)[XB_TMO])) break; if (_sp > XB_SPIN_CAP) { atomicAdd(&(bar)[XB_TMO], 1u); break; } } } } while (0)
struct XcdBarrier { unsigned* bar; unsigned x; volatile LAS unsigned* st; };
__device__ __forceinline__ XcdBarrier xcd_barrier_post(unsigned* bar, volatile LAS unsigned* st) {
    XcdBarrier b; b.bar = bar; b.x = xb_xcc_id(); b.st = st;
    if (threadIdx.x == 0) (void)xb_add(&bar[XB_XCNT(b.x)], 1u);
    return b;
}
__device__ __forceinline__ void xcd_barrier_complete(unsigned* bar, unsigned x, unsigned& nloc, unsigned& nx) {
    const unsigned G = gridDim.x * gridDim.y * gridDim.z;
    unsigned sum, cnt, mine, sp = 0u;
    for (;;) {
        sum = 0u; cnt = 0u; mine = 0u;
#pragma unroll
        for (unsigned j = 0; j < 16; ++j) { const unsigned c = xb_ld(&bar[XB_XCNT(j)]); sum += c; cnt += (c > 0u) ? 1u : 0u; mine = (j == x) ? c : mine; }
        if (sum == G) break;
        __builtin_amdgcn_s_sleep(1);
        if ((++sp & 255u) == 0u) { if (xb_ld(&bar[XB_TMO])) break; if (sp > XB_SPIN_CAP) { atomicAdd(&bar[XB_TMO], 1u); break; } }
    }
    nloc = mine > 0u ? mine : 1u; nx = cnt > 0u ? cnt : 1u;
}
__device__ __forceinline__ void xcd_barrier(const XcdBarrier& b) {
    asm volatile("s_waitcnt vmcnt(0)" ::: "memory");
    __syncthreads();
    if (threadIdx.x == 0) {
        unsigned* bar = b.bar;
        __builtin_amdgcn_s_waitcnt(0);
        unsigned nloc = b.st[0], nx = b.st[1];
        if (nloc == 0u) { xcd_barrier_complete(bar, b.x, nloc, nx); b.st[0] = nloc; b.st[1] = nx; }
        const unsigned old = xb_add(&bar[XB_XSUB(b.x)], 1u);
        const unsigned gen = old / nloc;
        if (old + 1u == (gen + 1u) * nloc) {
            __builtin_amdgcn_fence(__ATOMIC_RELEASE, "agent");
            asm volatile("s_waitcnt vmcnt(0)" ::: "memory");
            const unsigned og = xb_add(&bar[XB_TOP], 1u);
            const unsigned tg = og / nx;
            if (og + 1u == (tg + 1u) * nx) xb_add(&bar[XB_TOPGEN], 1u);
            else XB_SPIN(xb_ld(&bar[XB_TOPGEN]) == tg, bar);
            __builtin_amdgcn_fence(__ATOMIC_ACQUIRE, "agent");
            xb_add(&bar[XB_XGEN(b.x)], 1u);
            asm volatile("s_waitcnt vmcnt(0)" ::: "memory");
        } else {
            XB_SPIN(xb_ld(&bar[XB_XGEN(b.x)]) == gen, bar);
            __builtin_amdgcn_fence(__ATOMIC_ACQUIRE, "agent");
            asm volatile("s_waitcnt vmcnt(0)" ::: "memory");
        }
    }
    __syncthreads();
}

__global__ void __launch_bounds__(512, 2) fwd_mega(Params Pk) {
    extern __shared__ __attribute__((aligned(16))) unsigned char shm[];
    LAS unsigned char* lds = (LAS unsigned char*)shm;
    cg::grid_group grid = cg::this_grid();
    const int G = gridDim.x, bid = blockIdx.x, ngw = G * 8;
    volatile LAS unsigned* xst = (volatile LAS unsigned*)(lds + LDS_BYTES - 16);
    if (threadIdx.x == 0) { xst[0] = 0u; xst[1] = 0u; }
    __syncthreads();
    const XcdBarrier xb = xcd_barrier_post((unsigned*)(fresh_params()->ws + W_BAR), xst);
#define GSYNC() xcd_barrier(xb)
    for (int rp = 0; rp < REP_W; ++rp) { KP P = fresh_params(); phase_weights(P, lds); }
    for (int l = 0; l < DEPTH; ++l) {
        for (int rp = 0; rp < REP_P1; ++rp) { KP P = fresh_params(); const float* xin = l == 0 ? P->in[0] : P->out; phase_norm(xin, P->in[2] + l * DM, (bf16_t*)(P->ws + W_H)); }
        if (G == 0x7fffffff) grid.sync();
        GSYNC();
        for (int rp = 0; rp < REP_P2; ++rp) { KP P = fresh_params(); bf16_t* proj = (bf16_t*)(P->ws + W_PROJ); pg8::Gemm g{(const bf16_t*)(P->ws + W_H), (const bf16_t*)(P->ws + W_WIN + l * SZ_WIN), SEQ, NP, DM};
          pg8::StaticOrder S; S.init(SEQ, NP, G, bid);
          EpiProj E{proj, P->in[27] + l * 4 * DM};
          pg8::gemm_phase(lds, g, S, E); GSYNC(); }
        for (int rp = 0; rp < REP_P3; ++rp) { KP P = fresh_params();
        { const int tid = fresh_tid(), lane = tid & 63, gw = bid * 8 + (tid >> 6); for (int r2 = 0; r2 < REP_A; ++r2) for (int it = gw; it < 1536; it += ngw) a_prep_item(P, l, it, lane, lds + (tid >> 6) * 16384); }
        { const int tid = fresh_tid(), lane = tid & 63, gw = bid * 8 + (tid >> 6); for (int it = gw; it < SEQ; it += ngw) b_prep1_cq(P, l, it, lane); for (int it = gw; it < SEQ / 4; it += ngw) b_prep1_ckv(P, l, it, lane); }
        { const int tid = fresh_tid(), lane = tid & 63, gw = bid * 8 + (tid >> 6); for (int r2 = 0; r2 < REP_D1; ++r2) for (int it = gw; it < 4096; it += ngw) s5_item<false>(P, l, it, lane, lds + (tid >> 6) * 12800); }
        __syncthreads();
        for (int it = bid; it < 512; it += G) c1_item(P, l, it, lds); GSYNC(); }
        for (int rp = 0; rp < REP_P4; ++rp) { KP P = fresh_params(); const int scanW = 32, gemmW = G - scanW;
          if (bid < gemmW) {
              { pg8::Gemm g{(const bf16_t*)(P->ws + W_CQN), (const bf16_t*)(P->ws + W_WUQ + l * SZ_WUQ), SEQ, 768, 512};
                pg8::StaticOrder S; S.init(SEQ, 768, gemmW, bid); EpiBf16 E{(bf16_t*)(P->ws + W_QRAW), 768}; pg8::gemm_phase(lds, g, S, E); }
              { pg8::Gemm g{(const bf16_t*)(P->ws + W_CKVN), (const bf16_t*)(P->ws + W_WUKV + l * SZ_WUKV), SEQ, 1024, 256};
                pg8::StaticOrder S; S.init(SEQ, 1024, gemmW, (bid + gemmW - 96) % gemmW); EpiKV E{(bf16_t*)(P->ws + W_KVRAW), (bf16_t*)(P->ws + W_VBT)}; pg8::gemm_phase(lds, g, S, E); }
          } else {
              const int tid = fresh_tid(), nst = scanW * 512;
              LAS float* metaL = (LAS float*)lds;
              for (int i = tid; i < 1024; i += 512) metaL[i] = ((const float*)(P->ws + W_META))[i];
              __syncthreads();
              { const int e = (bid - gemmW - (scanW - 4)) * 512 + tid; if (e >= 0 && e < 2048) d2_elem(P, l, e); }
              c2_multi(P, (bid - gemmW) * 512 + tid, nst, metaL);
          }
          __syncthreads();
          unsigned* ticket = (unsigned*)(P->ws + W_BAR + 14336) + l * 64;
          volatile LAS int* tk = (volatile LAS int*)(lds + LDS_BYTES - 32);
          for (;;) {
              if (threadIdx.x == 0) tk[0] = (int)atomicAdd(ticket, 1u);
              __syncthreads();
              const int it = tk[0];
              __syncthreads();
              if (it >= 768) break;
              const int hh = it >> 6, nq = it & 63, g = hh >> 2, dsh = 2 * g, L = SEQ >> dsh, p0 = nq * 128, n_in = (p0 & (L - 1)) >> 7;
              const int kt_hi = p0 / 64 + 2, kt_lo = n_in == 0 ? p0 / 64 : p0 / 64 - 2;
              const float slope = exp2f(-8.f * (float)(hh + 1) / 12.f) * (float)(1 << dsh) * 1.4426950408889634f;
              attn_block<128>(lds, (const bf16_t*)(P->ws + W_QA) + ((size_t)hh * SEQ + p0) * 128, (const bf16_t*)(P->ws + W_KA) + (size_t)hh * SEQ * 128,
                              (const bf16_t*)(P->ws + W_VAT) + (size_t)hh * 128 * SEQ, p0, kt_lo, kt_hi, 128, slope, dsh,
                              (bf16_t*)(P->ws + W_OA) + (size_t)g * SEQ * 512, (float*)(P->ws + W_LSEA) + (size_t)g * SEQ * 4, hh & 3);
          } GSYNC(); }
        for (int rp = 0; rp < REP_P5; ++rp) { KP P = fresh_params();
        { const int tid = fresh_tid(), lane = tid & 63, gw = bid * 8 + (tid >> 6); for (int it = gw; it < SEQ; it += ngw) b_prep2_item(P, l, it, lane); }
        { const int tid = fresh_tid(), lane = tid & 63, gw = bid * 8 + (tid >> 6); for (int r2 = 0; r2 < REP_D3; ++r2) for (int it = gw; it < 4096; it += ngw) s5_item<true>(P, l, it, lane, lds + (tid >> 6) * 12800); }
        __syncthreads();
        for (int r2 = 0; r2 < REP_C3; ++r2) for (int it = bid; it < 512; it += G) c3_item(P, l, it, lds); GSYNC(); }
        for (int rp = 0; rp < REP_P6; ++rp) {
        for (int slot = bid; slot < 256; slot += G) { KP P = fresh_params();
            const int h = slot & 3, part = (slot >> 2) & 1, i0 = slot >> 3;
#pragma unroll 1
            for (int rep = 0; rep < 2; ++rep) {
                const int i = rep ? 63 - i0 : i0, nkb = i + 1, h0 = (nkb + 1) >> 1;
                const int kt_lo = part ? 2 * h0 : 0, kt_hi = part ? 2 * nkb : 2 * h0;
                attn_block<192>(lds, (const bf16_t*)(P->ws + W_QB) + ((size_t)h * SEQ + i * 128) * 192, (const bf16_t*)(P->ws + W_KB) + (size_t)h * SEQ * 192,
                                (const bf16_t*)(P->ws + W_VBT) + (size_t)h * 128 * SEQ, i * 128, kt_lo, kt_hi, 1 << 30, 0.f, 0,
                                (bf16_t*)(P->ws + W_OB) + (size_t)part * SEQ * 512, (float*)(P->ws + W_LSEB) + (size_t)part * SEQ * 4, h);
            }
        }
        GSYNC(); }
        for (int rp = 0; rp < REP_P7; ++rp) {
        { KP P = fresh_params(); bf16_t* proj = (bf16_t*)(P->ws + W_PROJ); pg8::Gemm g{(const bf16_t*)(P->ws + W_YD), (const bf16_t*)(P->ws + W_WGLU + l * SZ_WGLU), SEQ, 512, 512};
          pg8::StaticOrder S; S.init(SEQ, 512, G, bid);
          EpiGlu E{(const bf16_t*)(P->ws + W_YD), proj, P->in[25] + l * 512, (bf16_t*)(P->ws + W_YS)};
          pg8::gemm_phase(lds, g, S, E); }
        { KP P = fresh_params(); phase_combine(P); }
        GSYNC(); }
        for (int rp = 0; rp < REP_P8; ++rp) { KP P = fresh_params(); bf16_t* proj = (bf16_t*)(P->ws + W_PROJ); pg8::Gemm g{(const bf16_t*)(P->ws + W_YS), (const bf16_t*)(P->ws + W_WUP + l * SZ_WSQ), SEQ, DM, DM};
          pg8::StaticOrder S; S.init(SEQ, DM, G, bid);
          EpiUp E{proj, (bf16_t*)(P->ws + W_MERGED)};
          pg8::gemm_phase(lds, g, S, E); GSYNC(); }
        for (int rp = 0; rp < REP_SYNC; ++rp) GSYNC();
        for (int rp = 0; rp < (l == 0 ? REP_P9 : 1); ++rp) { KP P = fresh_params(); const float* xin = l == 0 ? P->in[0] : P->out; pg8::Gemm g{(const bf16_t*)(P->ws + W_MERGED), (const bf16_t*)(P->ws + W_WOUT + l * SZ_WSQ), SEQ, DM, DM};
          pg8::StaticOrder S; S.init(SEQ, DM, G, bid);
          EpiOut E{xin, P->out};
          pg8::gemm_phase(lds, g, S, E); GSYNC(); }
    }
}

extern "C" void kernel_launch(void* const* d_in, const int* in_sizes, int n_in, void* d_out, int out_size, void* d_ws, size_t ws_size, hipStream_t stream) {
    static int grid_blocks = 0;
    if (!grid_blocks) {
        int dev = 0, cus = 0, per_cu = 0;
        (void)hipGetDevice(&dev);
        (void)hipDeviceGetAttribute(&cus, hipDeviceAttributeMultiprocessorCount, dev);
        (void)hipFuncSetAttribute((const void*)fwd_mega, hipFuncAttributeMaxDynamicSharedMemorySize, LDS_BYTES);
        (void)hipOccupancyMaxActiveBlocksPerMultiprocessor(&per_cu, (const void*)fwd_mega, 512, LDS_BYTES);
        (void)hipGetLastError();
        grid_blocks = cus > 0 ? cus : 256;
        if (ws_size < W_END) fprintf(stderr, "workspace too small: %zu < %zu\n", ws_size, (size_t)W_END);
        fprintf(stderr, "grid %d (cus %d per_cu %d)\n", grid_blocks, cus, per_cu);
    }
    (void)hipMemsetAsync((unsigned char*)d_ws + W_BAR, 0, 16384, stream);
    Params p{};
    for (int i = 0; i < 29; ++i) p.in[i] = (const float*)d_in[i];
    p.out = (float*)d_out; p.ws = (unsigned char*)d_ws;
    void* args[] = {&p};
    hipError_t e = hipLaunchCooperativeKernel((const void*)fwd_mega, dim3(grid_blocks), dim3(512), args, LDS_BYTES, stream);
    if (e != hipSuccess) fprintf(stderr, "cooperative launch failed: %s\n", hipGetErrorString(e));
}
```
